# Optimizing an MI355X kernel written in HIP

```python
import math
import jax, jax.numpy as jnp
from jax import lax
import numpy as np

D_MODEL = 1024
BATCH = 32
SEQ = 2048
DEPTH = 4

CHUNK = 64
PLE_DIM = 256
MIX_WIDTH = D_MODEL
POOL_WIDTH = MIX_WIDTH // 2
SSM_WIDTH = MIX_WIDTH - POOL_WIDTH
POOL_WINDOWS = (2, 4, 8, 16)
POOL_GROUP = POOL_WIDTH // len(POOL_WINDOWS)
SSM_GROUP_CH = 16
SSM_GROUPS = SSM_WIDTH // SSM_GROUP_CH
SSM_STATE = 64
DT_MIN = 1e-3
DT_MAX = 1e-1
A_RE_MAX = -1e-4
_FF_RAW = -(-(8 * D_MODEL) // 3)
D_FF = -(-_FF_RAW // 256) * 256
DEEPNORM_ALPHA = (2.0 * DEPTH) ** 0.25
DEEPNORM_BETA = (8.0 * DEPTH) ** -0.25
LN_EPS = 1e-5

kernel_name = "hybrid_pool_s5_deepnorm_encoder"


def layer_norm(x, g, b):
    xf = x.astype(jnp.float32)
    mu = jnp.mean(xf, axis=-1, keepdims=True)
    var = jnp.mean(jnp.square(xf - mu), axis=-1, keepdims=True)
    y = (xf - mu) * lax.rsqrt(var + LN_EPS) * g.astype(jnp.float32) + b.astype(jnp.float32)
    return y.astype(x.dtype)


def multiscale_pool(u, w, b, scale):
    bsz, s, _ = u.shape
    uf = u.astype(jnp.float32)
    pos = jnp.arange(1, s + 1, dtype=jnp.float32)[None, :, None]
    outs = []
    for g, win in enumerate(POOL_WINDOWS):
        ug = uf[..., g * POOL_GROUP:(g + 1) * POOL_GROUP]
        c = jnp.cumsum(ug, axis=1)
        lag = jnp.pad(c[:, :-win], ((0, 0), (win, 0), (0, 0)))
        mean = (c - lag) / jnp.minimum(pos, float(win))
        outs.append(mean - ug)
    z = jnp.stack(outs, axis=2)
    y = jnp.einsum('bsgc,gcd->bsgd', z, w.astype(jnp.float32)).reshape(bsz, s, POOL_WIDTH)
    return (y + b.astype(jnp.float32)) * scale.astype(jnp.float32)


def s5_mixer(u, a_re, a_im, log_dt, b_re, b_im, c_re, c_im, d, glu_w, glu_b):
    bsz, s, _ = u.shape
    f32 = jnp.float32
    uf = u.astype(f32)
    ug = uf.reshape(bsz, s, SSM_GROUPS, SSM_GROUP_CH)
    lam = lax.complex(jnp.minimum(a_re.astype(f32), A_RE_MAX), a_im.astype(f32))
    dt = jnp.exp(log_dt.astype(f32))[:, None]
    lam_bar = jnp.exp(lam * dt)
    b_mat = lax.complex(b_re.astype(f32), b_im.astype(f32))
    b_bar = ((lam_bar - 1.0) / lam)[..., None] * b_mat
    bu = lax.complex(jnp.einsum('bsgc,gnc->bsgn', ug, jnp.real(b_bar)),
                     jnp.einsum('bsgc,gnc->bsgn', ug, jnp.imag(b_bar)))
    a_seq = jnp.broadcast_to(lam_bar, (1, s) + lam_bar.shape)

    def combine(left, right):
        a_l, x_l = left
        a_r, x_r = right
        return a_r * a_l, a_r * x_l + x_r

    _, states = lax.associative_scan(combine, (a_seq, bu), axis=1)
    y = (jnp.einsum('bsgn,gcn->bsgc', jnp.real(states), c_re.astype(f32))
         - jnp.einsum('bsgn,gcn->bsgc', jnp.imag(states), c_im.astype(f32)))
    y = y.reshape(bsz, s, SSM_WIDTH) + d.astype(f32) * uf
    y = jax.nn.gelu(y)
    return y * jax.nn.sigmoid(y @ glu_w.astype(f32) + glu_b.astype(f32))


def setup_inputs(seed: int = 0) -> dict:
    key = jax.random.key(seed)
    ks = jax.random.split(key, 27)
    L, D, M, H = DEPTH, D_MODEL, MIX_WIDTH, D_FF
    G, N, C = SSM_GROUPS, SSM_STATE, SSM_GROUP_CH
    nrm = lambda k, shape, std: jax.random.normal(k, shape, jnp.float32) * std
    xavier = lambda fi, fo: math.sqrt(2.0 / (fi + fo))
    n_idx = jnp.arange(N, dtype=jnp.float32)
    return {
        "x": nrm(ks[0], (BATCH, SEQ, D), 1.0),
        "p": nrm(ks[1], (L, BATCH, SEQ, PLE_DIM), 1.0),
        "w_in": nrm(ks[2], (L, D, M), D ** -0.5),
        "pool_w": nrm(ks[3], (L, len(POOL_WINDOWS), POOL_GROUP, POOL_GROUP), POOL_GROUP ** -0.5),
        "pool_b": nrm(ks[4], (L, POOL_WIDTH), 0.01),
        "pool_scale": 1.0 + nrm(ks[5], (L, POOL_WIDTH), 0.02),
        "ssm_a_re": -0.5 + nrm(ks[6], (L, G, N), 0.01),
        "ssm_a_im": math.pi * n_idx[None, None, :] + nrm(ks[7], (L, G, N), 0.01),
        "ssm_log_dt": jax.random.uniform(ks[8], (L, G), jnp.float32, math.log(DT_MIN), math.log(DT_MAX)),
        "ssm_b_re": nrm(ks[9], (L, G, N, C), (2.0 * C) ** -0.5),
        "ssm_b_im": nrm(ks[10], (L, G, N, C), (2.0 * C) ** -0.5),
        "ssm_c_re": nrm(ks[11], (L, G, C, N), N ** -0.5),
        "ssm_c_im": nrm(ks[12], (L, G, C, N), N ** -0.5),
        "ssm_d": nrm(ks[13], (L, SSM_WIDTH), 1.0),
        "ssm_glu_w": nrm(ks[14], (L, SSM_WIDTH, SSM_WIDTH), SSM_WIDTH ** -0.5),
        "ssm_glu_b": nrm(ks[15], (L, SSM_WIDTH), 0.01),
        "w_out": nrm(ks[16], (L, M, D), xavier(M, D) * DEEPNORM_BETA),
        "ln1_g": 1.0 + nrm(ks[17], (L, D), 0.02),
        "ln1_b": nrm(ks[18], (L, D), 0.01),
        "ffn_w1": nrm(ks[19], (L, D, H), xavier(D, H)),
        "ffn_w3": nrm(ks[20], (L, D, H), xavier(D, H)),
        "ffn_w2": nrm(ks[21], (L, H, D), xavier(H, D) * DEEPNORM_BETA),
        "ple_w": nrm(ks[22], (L, PLE_DIM, D), xavier(PLE_DIM, D) * DEEPNORM_BETA),
        "ple_gate_w": nrm(ks[23], (L, D, D), D ** -0.5),
        "ln2_g": 1.0 + nrm(ks[24], (L, D), 0.02),
        "ln2_b": nrm(ks[25], (L, D), 0.01),
    }


def reference(x, p, w_in, pool_w, pool_b, pool_scale, ssm_a_re, ssm_a_im, ssm_log_dt,
              ssm_b_re, ssm_b_im, ssm_c_re, ssm_c_im, ssm_d, ssm_glu_w, ssm_glu_b,
              w_out, ln1_g, ln1_b, ffn_w1, ffn_w3, ffn_w2, ple_w, ple_gate_w, ln2_g, ln2_b):
    h = x
    for i in range(DEPTH):
        u = h @ w_in[i]
        y_pool = multiscale_pool(u[..., :POOL_WIDTH], pool_w[i], pool_b[i], pool_scale[i])
        y_ssm = s5_mixer(u[..., POOL_WIDTH:], ssm_a_re[i], ssm_a_im[i], ssm_log_dt[i],
                         ssm_b_re[i], ssm_b_im[i], ssm_c_re[i], ssm_c_im[i], ssm_d[i],
                         ssm_glu_w[i], ssm_glu_b[i])
        mix = jnp.concatenate([y_pool, y_ssm], axis=-1).astype(h.dtype) @ w_out[i]
        h = layer_norm(DEEPNORM_ALPHA * h + mix, ln1_g[i], ln1_b[i])
        f = (jax.nn.silu(h @ ffn_w1[i]) * (h @ ffn_w3[i])) @ ffn_w2[i]
        r = DEEPNORM_ALPHA * h + f
        e = (p[i] @ ple_w[i]) * jax.nn.sigmoid(r @ ple_gate_w[i])
        h = layer_norm(r + e, ln2_g[i], ln2_b[i])
    return h
```

```cpp
#include <hip/hip_runtime.h>
#include <hip/hip_cooperative_groups.h>
#include <cstdio>
namespace cg = cooperative_groups;

#define LAS __attribute__((address_space(3)))
typedef unsigned short bf16_t;
typedef short bf16x8 __attribute__((ext_vector_type(8)));
typedef float f32x4 __attribute__((ext_vector_type(4)));
typedef float f32x2 __attribute__((ext_vector_type(2)));
typedef unsigned u32x4 __attribute__((ext_vector_type(4)));

constexpr int T_ = 65536, D_ = 1024, H_ = 2816, NL_ = 4, SEQ_ = 2048, PLE_ = 256;
constexpr float ALPHA = 1.6817928305074290f;
constexpr float LN_EPS = 1e-5f;
constexpr int LDS_BYTES = 144 * 1024;

constexpr size_t MiB = (size_t)1 << 20;
constexpr size_t WS_WIN = 0, WS_WOUT = 8 * MiB, WS_GATE = 16 * MiB, WS_GLU = 24 * MiB, WS_PLE = 26 * MiB, WS_W13 = 28 * MiB, WS_W2 = 72 * MiB,
                 WS_WCOMB = 94 * MiB, WS_CVEC = 102 * MiB, WS_STATS = 103 * MiB, WS_LBP = 107 * MiB, WS_BBAR = 112 * MiB, WS_KMAT = 113 * MiB,
                 WS_PG = 121 * MiB, WS_LOC = 153 * MiB, WS_BAUG = 169 * MiB, WS_X1 = 241 * MiB, WS_X2 = 369 * MiB, WS_PB = 497 * MiB, WS_BIG = 625 * MiB,
                 WS_STATS2 = 977 * MiB, WS_END = 993 * MiB;
constexpr size_t BIG_AAUG = 0, BIG_Q = 72 * MiB, BIG_YG = 136 * MiB, BIG_MIX = 200 * MiB, BIG_E = 0;
constexpr size_t WS_BAR = WS_CVEC + 768 * 1024;
constexpr int CVEC_PER_LAYER = 2 * 1024 + 2 * 5632;

struct Params { const float* in[26]; float* out; unsigned char* ws; };

__device__ __forceinline__ bf16_t f2bf(float f) { unsigned u = __float_as_uint(f); u += 0x7FFFu + ((u >> 16) & 1u); return (bf16_t)(u >> 16); }
__device__ __forceinline__ float bf2f(bf16_t b) { return __uint_as_float(((unsigned)b) << 16); }
__device__ __forceinline__ unsigned cvt_pk(float lo, float hi) { unsigned r; asm volatile("v_cvt_pk_bf16_f32 %0, %1, %2" : "=v"(r) : "v"(lo), "v"(hi)); return r; }
__device__ __forceinline__ float bflo(unsigned w) { return __uint_as_float(w << 16); }
__device__ __forceinline__ float bfhi(unsigned w) { return __uint_as_float(w & 0xffff0000u); }
__device__ __forceinline__ u32x4 pack8(const f32x4 a, const f32x4 b) { u32x4 w; w.x = cvt_pk(a[0], a[1]); w.y = cvt_pk(a[2], a[3]); w.z = cvt_pk(b[0], b[1]); w.w = cvt_pk(b[2], b[3]); return w; }
__device__ __forceinline__ void unpack8(const u32x4 w, f32x4& a, f32x4& b) { a = (f32x4){bflo(w.x), bfhi(w.x), bflo(w.y), bfhi(w.y)}; b = (f32x4){bflo(w.z), bfhi(w.z), bflo(w.w), bfhi(w.w)}; }
typedef unsigned u32x2 __attribute__((ext_vector_type(2)));
__device__ __forceinline__ void hl_store(bf16_t* X, signed char* LO, size_t off, const f32x4 va, const f32x4 vb) {
    const unsigned t0 = __float_as_uint(va[0]) + 0x8000u, t1 = __float_as_uint(va[1]) + 0x8000u, t2 = __float_as_uint(va[2]) + 0x8000u, t3 = __float_as_uint(va[3]) + 0x8000u;
    const unsigned t4 = __float_as_uint(vb[0]) + 0x8000u, t5 = __float_as_uint(vb[1]) + 0x8000u, t6 = __float_as_uint(vb[2]) + 0x8000u, t7 = __float_as_uint(vb[3]) + 0x8000u;
    u32x4 w; w.x = __builtin_amdgcn_perm(t1, t0, 0x07060302u); w.y = __builtin_amdgcn_perm(t3, t2, 0x07060302u); w.z = __builtin_amdgcn_perm(t5, t4, 0x07060302u); w.w = __builtin_amdgcn_perm(t7, t6, 0x07060302u);
    u32x2 l; l.x = __builtin_amdgcn_perm(t1, t0, 0x0c0c0501u) | __builtin_amdgcn_perm(t3, t2, 0x05010c0cu); l.y = __builtin_amdgcn_perm(t5, t4, 0x0c0c0501u) | __builtin_amdgcn_perm(t7, t6, 0x05010c0cu);
    *(u32x4*)(X + off) = w; *(u32x2*)(LO + off) = l;
}
__device__ __forceinline__ void hl_decode(const u32x4 w, const u32x2 l, f32x4& va, f32x4& vb) {
    va[0] = __uint_as_float(__builtin_amdgcn_perm(w.x, l.x, 0x0504000cu) - 0x7f80u); va[1] = __uint_as_float(__builtin_amdgcn_perm(w.x, l.x, 0x0706010cu) - 0x7f80u);
    va[2] = __uint_as_float(__builtin_amdgcn_perm(w.y, l.x, 0x0504020cu) - 0x7f80u); va[3] = __uint_as_float(__builtin_amdgcn_perm(w.y, l.x, 0x0706030cu) - 0x7f80u);
    vb[0] = __uint_as_float(__builtin_amdgcn_perm(w.z, l.y, 0x0504000cu) - 0x7f80u); vb[1] = __uint_as_float(__builtin_amdgcn_perm(w.z, l.y, 0x0706010cu) - 0x7f80u);
    vb[2] = __uint_as_float(__builtin_amdgcn_perm(w.w, l.y, 0x0504020cu) - 0x7f80u); vb[3] = __uint_as_float(__builtin_amdgcn_perm(w.w, l.y, 0x0706030cu) - 0x7f80u);
}
__device__ __forceinline__ void hl_load(const bf16_t* X, const signed char* LO, size_t off, f32x4& va, f32x4& vb) { hl_decode(*(const u32x4*)(X + off), *(const u32x2*)(LO + off), va, vb); }
__device__ __forceinline__ float sigmoidf_(float v) { return __builtin_amdgcn_rcpf(1.0f + __expf(-v)); }
__device__ __forceinline__ float gelu_tanh(float y) { const float z = 1.5957691216057308f * (y + 0.044715f * y * y * y); return y * sigmoidf_(z); }

#define XB_TMO      128
#define XB_XCNT(j)  (256  + 64 * (j))
#define XB_XSUB(j)  (1280 + 64 * (j))
#define XB_XGEN(j)  (2304 + 64 * (j))
#define XB_TOP      3328
#define XB_TOPGEN   3392
#define XCD_BAR_WORDS 3456
#define XB_SPIN_CAP (1u << 18)
__device__ __forceinline__ unsigned xb_ld(unsigned* p)              { return __hip_atomic_load(p, __ATOMIC_RELAXED, __HIP_MEMORY_SCOPE_AGENT); }
__device__ __forceinline__ unsigned xb_add(unsigned* p, unsigned v) { return __hip_atomic_fetch_add(p, v, __ATOMIC_RELAXED, __HIP_MEMORY_SCOPE_AGENT); }
__device__ __forceinline__ unsigned xb_xcc_id() { return (unsigned)__builtin_amdgcn_s_getreg((3 << 11) | 20) & 0xFu; }
#define XB_SPIN(cond, bar) do { unsigned _sp = 0; while (cond) { __builtin_amdgcn_s_sleep(1); \
    if ((++_sp & 255u) == 0u) { if (xb_ld(&(bar)[XB_TMO])) break; if (_sp > XB_SPIN_CAP) { atomicAdd(&(bar)[XB_TMO], 1u); break; } } } } while (0)
struct XcdBarrier { unsigned* bar; unsigned x; volatile LAS unsigned* st; };
__device__ __forceinline__ XcdBarrier xcd_barrier_post(unsigned* bar, volatile LAS unsigned* st) {
    XcdBarrier b; b.bar = bar; b.x = xb_xcc_id(); b.st = st;
    if (threadIdx.x == 0) (void)xb_add(&bar[XB_XCNT(b.x)], 1u);
    return b;
}
__device__ __forceinline__ void xcd_barrier_complete(unsigned* bar, unsigned x, unsigned& nloc, unsigned& nx) {
    const unsigned G = gridDim.x * gridDim.y * gridDim.z;
    unsigned sum, cnt, mine, sp = 0u;
    for (;;) {
        sum = 0u; cnt = 0u; mine = 0u;
#pragma unroll
        for (unsigned j = 0; j < 16; ++j) { const unsigned c = xb_ld(&bar[XB_XCNT(j)]); sum += c; cnt += (c > 0u) ? 1u : 0u; mine = (j == x) ? c : mine; }
        if (sum == G) break;
        __builtin_amdgcn_s_sleep(1);
        if ((++sp & 255u) == 0u) { if (xb_ld(&bar[XB_TMO])) break; if (sp > XB_SPIN_CAP) { atomicAdd(&bar[XB_TMO], 1u); break; } }
    }
    nloc = mine > 0u ? mine : 1u; nx = cnt > 0u ? cnt : 1u;
}
__device__ __forceinline__ void xcd_barrier(const XcdBarrier& b) {
    asm volatile("s_waitcnt vmcnt(0)" ::: "memory");
    __syncthreads();
    if (threadIdx.x == 0) {
        unsigned* bar = b.bar;
        __builtin_amdgcn_s_waitcnt(0);
        unsigned nloc = b.st[0], nx = b.st[1];
        if (nloc == 0u) { xcd_barrier_complete(bar, b.x, nloc, nx); b.st[0] = nloc; b.st[1] = nx; }
        const unsigned old = xb_add(&bar[XB_XSUB(b.x)], 1u);
        const unsigned gen = old / nloc;
        if (old + 1u == (gen + 1u) * nloc) {
            __builtin_amdgcn_fence(__ATOMIC_RELEASE, "agent");
            asm volatile("s_waitcnt vmcnt(0)" ::: "memory");
            const unsigned og = xb_add(&bar[XB_TOP], 1u);
            const unsigned tg = og / nx;
            if (og + 1u == (tg + 1u) * nx) xb_add(&bar[XB_TOPGEN], 1u);
            else XB_SPIN(xb_ld(&bar[XB_TOPGEN]) == tg, bar);
            __builtin_amdgcn_fence(__ATOMIC_ACQUIRE, "agent");
            xb_add(&bar[XB_XGEN(b.x)], 1u);
            asm volatile("s_waitcnt vmcnt(0)" ::: "memory");
        } else {
            XB_SPIN(xb_ld(&bar[XB_XGEN(b.x)]) == gen, bar);
            __builtin_amdgcn_fence(__ATOMIC_ACQUIRE, "agent");
            asm volatile("s_waitcnt vmcnt(0)" ::: "memory");
        }
    }
    __syncthreads();
}

constexpr int BM = 256, BK = 64, HALF = 128, HTB = HALF * BK * 2, NXCD = 8, WGM = 8;
__device__ __forceinline__ int lds_byte(int r, int c) { const int st = (r >> 4) * 2 + (c >> 5), rr = r & 15, cc = c & 31, ob = rr * 64 + cc * 2; return st * 1024 + (ob ^ (((ob >> 9) & 1) << 5)); }
__device__ __forceinline__ void stage_rc(int b, int& R, int& C) { const int st = b / 1024, sb = b % 1024, swz = sb ^ (((sb >> 9) & 1) << 5); R = (st >> 1) * 16 + swz / 64; C = (st & 1) * 32 + (swz % 64) / 2; }
__device__ __forceinline__ int perm32(int rho) { const int n = rho >> 4, i = rho & 15; return 8 * (i >> 2) + 4 * n + (i & 3); }

struct Unit { int pm, pn, g; };
struct Gemm { const bf16_t* A; const bf16_t* B; int lda, ldb, K; size_t batchA, batchB; int hzero; };
struct Sched {
    int nM, nN, per, tot, G, c;
    __device__ void init(int M, int N, int nG, int G_, int c_) { nM = M / BM; nN = N / BM; per = nM * nN; tot = per * nG; G = G_; c = c_; }
    __device__ bool next(int i, Unit& u) const {
        const long L = (long)i * G + c; if (L >= tot) return false;
        int wgid = (int)L; { const int q = tot / NXCD, r = tot % NXCD, xcd = wgid % NXCD, off = wgid / NXCD; wgid = (xcd < r ? xcd * (q + 1) : r * (q + 1) + (xcd - r) * q) + off; }
        u.g = wgid / per; const int w = wgid % per;
        const int nig = WGM * nN, gid = w / nig, fm = gid * WGM, gsz = (nM - fm) < WGM ? (nM - fm) : WGM;
        u.pm = fm + ((w % nig) % gsz); u.pn = (w % nig) / gsz; return true;
    }
};

template <class Epi>
__device__ __forceinline__ void gemm_phase(LAS unsigned char* lds, const Gemm g, const Sched& S, const Epi& E) {
    int tid = threadIdx.x; asm volatile("" : "+v"(tid));
    const int wid = __builtin_amdgcn_readfirstlane(tid >> 6), lane = tid & 63, wr = wid >> 2, wc = wid & 3, fr = lane & 15, fq = lane >> 4;
    const int nt = g.K / BK;
    unsigned voffA[2], voffB[2];
#pragma unroll
    for (int i = 0; i < 2; ++i) { int R, C; stage_rc(tid * 16 + i * 8192, R, C); const int Rb = (R & ~31) + perm32(R & 31);
        voffA[i] = (unsigned)(R * g.lda + C) * 2u; voffB[i] = (unsigned)(Rb * g.ldb + C) * 2u; }
    const size_t kstep = (size_t)(BK * 2);
    const size_t hstepA = (size_t)HALF * g.lda * 2, hstepB = g.hzero ? (size_t)0 : (size_t)HALF * g.ldb * 2;
    const size_t tstepA = 2 * (size_t)HALF * g.lda * 2, tstepB = 2 * (size_t)HALF * g.ldb * 2;
    const unsigned ldsw = (unsigned)wid * 1024u;
    const int aoff = lds_byte(wr * 64 + fr, fq * 8), boff = lds_byte(wc * 32 + fr, fq * 8);
#define G_SA(b, h) (((b) * 2 + (h)) * HTB)
#define G_SB(b, h) ((4 + (b) * 2 + (h)) * HTB)
#define G_STAGE(bufoff, gbase, voff) do { _Pragma("unroll") for (int _i = 0; _i < 2; ++_i) \
        __builtin_amdgcn_global_load_lds((const unsigned*)((const char*)(gbase) + (voff)[_i]), (LAS unsigned*)(lds + (bufoff) + ldsw + _i * 8192), 16, 0, 0); } while (0)
#define G_LDA(dst, b, h) do { _Pragma("unroll") for (int m = 0; m < 4; ++m) _Pragma("unroll") for (int k = 0; k < 2; ++k) dst[m][k] = *(const LAS bf16x8*)(lds + G_SA(b, h) + aoff + m * 2048 + k * 1024); } while (0)
#define G_LDB(dst, b, h) do { _Pragma("unroll") for (int n = 0; n < 2; ++n) _Pragma("unroll") for (int k = 0; k < 2; ++k) dst[n][k] = *(const LAS bf16x8*)(lds + G_SB(b, h) + boff + n * 2048 + k * 1024); } while (0)
#define G_MMA(ai, bj, At, Bt) do { __builtin_amdgcn_s_setprio(1); _Pragma("unroll") for (int m = 0; m < 4; ++m) _Pragma("unroll") for (int n = 0; n < 2; ++n) _Pragma("unroll") for (int k = 0; k < 2; ++k) \
        acc[ai][bj][m][n] = __builtin_amdgcn_mfma_f32_16x16x32_bf16(Bt[n][k], At[m][k], acc[ai][bj][m][n], 0, 0, 0); __builtin_amdgcn_s_setprio(0); } while (0)
#define G_WAIT_V(n) asm volatile("s_waitcnt vmcnt(" #n ")" ::: "memory")
#define G_WAIT_L(n) asm volatile("s_waitcnt lgkmcnt(" #n ")" ::: "memory")
#define G_BAR __builtin_amdgcn_s_barrier()
#define G_SCHED __builtin_amdgcn_sched_barrier(0)
    Unit cur, nxt; int ui = 0;
    if (!S.next(0, cur)) return;
    f32x4 acc[2][2][4][2];
#pragma unroll
    for (int a = 0; a < 2; ++a)
#pragma unroll
        for (int b = 0; b < 2; ++b)
#pragma unroll
            for (int m = 0; m < 4; ++m)
#pragma unroll
                for (int n = 0; n < 2; ++n) acc[a][b][m][n] = (f32x4){0.f, 0.f, 0.f, 0.f};
    bf16x8 At[4][2], B0[2][2], B1[2][2];
    const char* cA = (const char*)g.A + (size_t)cur.g * g.batchA + (size_t)cur.pm * tstepA; const char* cB = (const char*)g.B + (size_t)cur.g * g.batchB + (size_t)cur.pn * tstepB;
    G_STAGE(G_SB(0, 0), cB, voffB); G_STAGE(G_SA(0, 0), cA, voffA); G_STAGE(G_SB(0, 1), cB + hstepB, voffB); G_STAGE(G_SA(0, 1), cA + hstepA, voffA);
    if (wr == 1) G_BAR;
    G_WAIT_V(4); G_BAR;
    G_STAGE(G_SB(1, 0), cB + kstep, voffB); G_STAGE(G_SA(1, 0), cA + kstep, voffA); G_STAGE(G_SB(1, 1), cB + hstepB + kstep, voffB);
    G_WAIT_V(6); G_BAR;
    for (;;) {
        const bool has_next = S.next(ui + 1, nxt);
        const char* nA = has_next ? (const char*)g.A + (size_t)nxt.g * g.batchA + (size_t)nxt.pm * tstepA : cA;
        const char* nB = has_next ? (const char*)g.B + (size_t)nxt.g * g.batchB + (size_t)nxt.pn * tstepB : cB;
        for (int t = 0; t < nt; t += 2) {
            const bool last = (t == nt - 2);
            const char* a1 = cA + (size_t)(t + 1) * kstep;
            const char* a2 = last ? nA : cA + (size_t)(t + 2) * kstep; const char* b2 = last ? nB : cB + (size_t)(t + 2) * kstep;
            const char* a3 = a2 + kstep; const char* b3 = b2 + kstep;
            G_LDB(B0, 0, 0); G_SCHED; G_LDA(At, 0, 0); G_STAGE(G_SA(1, 1), a1 + hstepA, voffA);
            G_WAIT_L(8); G_BAR; G_WAIT_L(0); G_MMA(0, 0, At, B0); G_BAR; G_SCHED;
            G_LDB(B1, 0, 1); G_STAGE(G_SB(0, 0), b2, voffB);
            G_BAR; G_WAIT_L(0); G_MMA(0, 1, At, B1); G_BAR;
            G_LDA(At, 0, 1); G_STAGE(G_SA(0, 0), a2, voffA);
            G_BAR; G_WAIT_L(0); G_MMA(1, 0, At, B0); G_BAR; G_SCHED;
            G_STAGE(G_SB(0, 1), b2 + hstepB, voffB);
            G_WAIT_V(6); G_BAR; G_MMA(1, 1, At, B1); G_BAR;
            G_LDB(B0, 1, 0); G_SCHED; G_LDA(At, 1, 0); G_STAGE(G_SA(0, 1), a2 + hstepA, voffA);
            G_WAIT_L(8); G_BAR; G_WAIT_L(0); G_MMA(0, 0, At, B0); G_BAR; G_SCHED;
            G_LDB(B1, 1, 1); G_STAGE(G_SB(1, 0), b3, voffB);
            G_BAR; G_WAIT_L(0); G_MMA(0, 1, At, B1); G_BAR;
            G_LDA(At, 1, 1); G_STAGE(G_SA(1, 0), a3, voffA);
            G_BAR; G_WAIT_L(0); G_MMA(1, 0, At, B0); G_BAR; G_SCHED;
            G_STAGE(G_SB(1, 1), b3 + hstepB, voffB);
            G_WAIT_V(6); G_BAR; G_MMA(1, 1, At, B1); G_BAR;
        }
        { int fr2 = fr, fq2 = fq; asm volatile("" : "+v"(fr2), "+v"(fq2));
          E(acc, cur, wr, wc, fr2, fq2); }
        if (!has_next) break;
#pragma unroll
        for (int a = 0; a < 2; ++a)
#pragma unroll
            for (int b = 0; b < 2; ++b)
#pragma unroll
                for (int m = 0; m < 4; ++m)
#pragma unroll
                    for (int n = 0; n < 2; ++n) acc[a][b][m][n] = (f32x4){0.f, 0.f, 0.f, 0.f};
        cur = nxt; cA = nA; cB = nB; ++ui;
    }
    G_WAIT_V(0);
    if (wr == 0) G_BAR;
    G_BAR;
#undef G_SA
#undef G_SB
#undef G_STAGE
#undef G_LDA
#undef G_LDB
#undef G_MMA
#undef G_WAIT_V
#undef G_WAIT_L
#undef G_BAR
#undef G_SCHED
}

typedef f32x4 Acc[2][2][4][2];
__device__ __forceinline__ void row_stats(const float* st, int row, bool ln, float& mu, float& rstd) {
    if (ln) { const f32x4 a = *(const f32x4*)(st + 8 * (size_t)row), b = *(const f32x4*)(st + 8 * (size_t)row + 4); const float sx = (a[0] + a[2]) + (b[0] + b[2]), sy = (a[1] + a[3]) + (b[1] + b[3]);
        mu = sx * (1.0f / 1024.0f); const float var = sy * (1.0f / 1024.0f) - mu * mu; rstd = __builtin_amdgcn_rsqf(var + LN_EPS); }
    else { mu = 0.f; rstd = 1.f; }
}
#define ROW_STATS8(st, lnflag, MU, RS) float MU[8], RS[8]; { f32x4 sa_[8], sb_[8]; \
    _Pragma("unroll") for (int r_ = 0; r_ < 8; ++r_) { const int row_ = ROW_OF(u, r_ >> 2, r_ & 3); if (lnflag) { sa_[r_] = *(const f32x4*)((st) + 8 * (size_t)row_); sb_[r_] = *(const f32x4*)((st) + 8 * (size_t)row_ + 4); } } \
    _Pragma("unroll") for (int r_ = 0; r_ < 8; ++r_) { if (lnflag) { const float sx_ = (sa_[r_][0] + sa_[r_][2]) + (sb_[r_][0] + sb_[r_][2]), sy_ = (sa_[r_][1] + sa_[r_][3]) + (sb_[r_][1] + sb_[r_][3]); \
        MU[r_] = sx_ * (1.0f / 1024.0f); RS[r_] = __builtin_amdgcn_rsqf(sy_ * (1.0f / 1024.0f) - MU[r_] * MU[r_] + LN_EPS); } else { MU[r_] = 0.f; RS[r_] = 1.f; } \
        asm volatile("" : "+v"(MU[r_]), "+v"(RS[r_])); } asm volatile("" ::: "memory"); __builtin_amdgcn_sched_barrier(0); }
#define EPI_ROWS(ai, m) for (int ai = 0; ai < 2; ++ai) for (int m = 0; m < 4; ++m)
#define ROW_OF(u, ai, m) ((u).pm * BM + (ai) * HALF + wr * 64 + (m) * 16 + fr)
#define COL_OF(u, bj) ((u).pn * BM + (bj) * HALF + wc * 32 + 8 * fq)

#define ROWLOOP _Pragma("unroll") for (int ai = 0; ai < 2; ++ai) _Pragma("unroll") for (int m = 0; m < 4; ++m)
#define BJLOOP _Pragma("unroll") for (int bj = 0; bj < 2; ++bj)
#define PIN(ai, m) asm volatile("" : "+v"(acc[ai][0][m][0]), "+v"(acc[ai][0][m][1]), "+v"(acc[ai][1][m][0]), "+v"(acc[ai][1][m][1]))
#define FENCE1 do { asm volatile("" ::: "memory"); __builtin_amdgcn_sched_barrier(0); } while (0)
#define FENCE2 do { if (m & 1) { asm volatile("" ::: "memory"); __builtin_amdgcn_sched_barrier(0); } } while (0)

struct EpiIn {
    const float* st; const float* c1; const float* c2; bf16_t* Q; bf16_t* Aaug; int ln;
    __device__ __forceinline__ void operator()(Acc& acc, const Unit& u, int wr, int wc, int fr, int fq) const {
        {
            ROW_STATS8(st, ln, mu8, rs8);
            f32x4 k1a[2], k1b[2], k2a[2], k2b[2]; const f32x4 z = {0.f, 0.f, 0.f, 0.f};
            BJLOOP { const int c0 = COL_OF(u, bj); k1a[bj] = ln ? *(const f32x4*)(c1 + c0) : z; k1b[bj] = ln ? *(const f32x4*)(c1 + c0 + 4) : z; k2a[bj] = ln ? *(const f32x4*)(c2 + c0) : z; k2b[bj] = ln ? *(const f32x4*)(c2 + c0 + 4) : z; }
            ROWLOOP { const float mu = mu8[ai * 4 + m], rstd = rs8[ai * 4 + m];
                BJLOOP { acc[ai][bj][m][0] = (acc[ai][bj][m][0] - mu * k1a[bj]) * rstd + k2a[bj]; acc[ai][bj][m][1] = (acc[ai][bj][m][1] - mu * k1b[bj]) * rstd + k2b[bj]; }
                PIN(ai, m); FENCE2; }
        }
        asm volatile("" : "+v"(fr), "+v"(fq) :: "memory");
        BJLOOP { const int c0 = COL_OF(u, bj);
            ROWLOOP { const int row = ROW_OF(u, ai, m); const u32x4 w = pack8(acc[ai][bj][m][0], acc[ai][bj][m][1]);
                if (c0 < 512) *(u32x4*)(Q + (size_t)row * 512 + c0) = w;
                else { const int cc = c0 - 512, gg = cc >> 4, c = cc & 15; *(u32x4*)(Aaug + ((size_t)gg * 1024 + (row >> 6)) * 1152 + (row & 63) * 16 + c) = w; } FENCE2; } }
    }
};
struct EpiLoc {
    float* Loc;
    __device__ __forceinline__ void operator()(Acc& acc, const Unit& u, int wr, int wc, int fr, int fq) const {
        const int c0 = wc * 32 + 8 * fq;
        ROWLOOP { const int row = ROW_OF(u, ai, m); float* dst = Loc + ((size_t)u.g * 1024 + row) * 128 + c0;
            *(f32x4*)dst = acc[ai][0][m][0]; *(f32x4*)(dst + 4) = acc[ai][0][m][1]; FENCE2; }
    }
};
struct EpiSsm {
    const bf16_t* Aaug; const float* dvec; bf16_t* YG;
    __device__ __forceinline__ void operator()(Acc& acc, const Unit& u, int wr, int wc, int fr, int fq) const {
        {
            f32x4 da[2], db[2]; u32x4 uw[2][2];
            BJLOOP { const int c = COL_OF(u, bj) & 15; da[bj] = *(const f32x4*)(dvec + u.g * 16 + c); db[bj] = *(const f32x4*)(dvec + u.g * 16 + c + 4); }
#define SSM_LOAD(r, s) do { const int row_ = ROW_OF(u, (r) >> 2, (r) & 3); BJLOOP uw[s][bj] = *(const u32x4*)(Aaug + ((size_t)u.g * 1024 + row_) * 1152 + COL_OF(u, bj)); } while (0)
            SSM_LOAD(0, 0);
#pragma unroll
            for (int r = 0; r < 8; ++r) {
                if (r + 1 < 8) SSM_LOAD(r + 1, (r + 1) & 1);
                __builtin_amdgcn_sched_barrier(0);
                const int ai = r >> 2, m = r & 3, s = r & 1;
                BJLOOP { f32x4 ua, ub; unpack8(uw[s][bj], ua, ub);
                    f32x4 ya = acc[ai][bj][m][0] + da[bj] * ua, yb = acc[ai][bj][m][1] + db[bj] * ub;
#pragma unroll
                    for (int j = 0; j < 4; ++j) { ya[j] = gelu_tanh(ya[j]); yb[j] = gelu_tanh(yb[j]); }
                    acc[ai][bj][m][0] = ya; acc[ai][bj][m][1] = yb; }
                PIN(ai, m); asm volatile("" ::: "memory"); __builtin_amdgcn_sched_barrier(0);
            }
#undef SSM_LOAD
        }
        asm volatile("" : "+v"(fr), "+v"(fq) :: "memory");
        BJLOOP { const int c0 = COL_OF(u, bj), tl = c0 >> 4, c = c0 & 15;
            ROWLOOP { const int row = ROW_OF(u, ai, m); *(u32x4*)(YG + ((size_t)row * 64 + tl) * 512 + u.g * 16 + c) = pack8(acc[ai][bj][m][0], acc[ai][bj][m][1]); FENCE2; } }
    }
};
struct EpiGlu {
    const bf16_t* YG; const float* bias; bf16_t* MIX;
    __device__ __forceinline__ void operator()(Acc& acc, const Unit& u, int wr, int wc, int fr, int fq) const {
        {
            f32x4 ba[2], bb[2]; u32x4 yw[2][2];
            BJLOOP { const int c0 = COL_OF(u, bj); ba[bj] = *(const f32x4*)(bias + c0); bb[bj] = *(const f32x4*)(bias + c0 + 4); }
#define GLU_LOAD(r, s) do { const int row_ = ROW_OF(u, (r) >> 2, (r) & 3); BJLOOP yw[s][bj] = *(const u32x4*)(YG + (size_t)row_ * 512 + COL_OF(u, bj)); } while (0)
            GLU_LOAD(0, 0);
#pragma unroll
            for (int r = 0; r < 8; ++r) {
                if (r + 1 < 8) GLU_LOAD(r + 1, (r + 1) & 1);
                __builtin_amdgcn_sched_barrier(0);
                const int ai = r >> 2, m = r & 3, s = r & 1;
                BJLOOP { f32x4 ya, yb; unpack8(yw[s][bj], ya, yb);
                    f32x4 ga = acc[ai][bj][m][0] + ba[bj], gb = acc[ai][bj][m][1] + bb[bj];
#pragma unroll
                    for (int j = 0; j < 4; ++j) { ga[j] = ya[j] * sigmoidf_(ga[j]); gb[j] = yb[j] * sigmoidf_(gb[j]); }
                    acc[ai][bj][m][0] = ga; acc[ai][bj][m][1] = gb; }
                PIN(ai, m); asm volatile("" ::: "memory"); __builtin_amdgcn_sched_barrier(0);
            }
#undef GLU_LOAD
        }
        asm volatile("" : "+v"(fr), "+v"(fq) :: "memory");
        BJLOOP { const int c0 = COL_OF(u, bj);
            ROWLOOP { const int row = ROW_OF(u, ai, m); *(u32x4*)(MIX + (size_t)row * 1024 + 512 + c0) = pack8(acc[ai][bj][m][0], acc[ai][bj][m][1]); FENCE2; } }
    }
};
__device__ __forceinline__ void stats_publish(LAS unsigned char* red, float* st, const Acc& acc, const Unit& u, int wr, int wc, int fr, int fq) {
    LAS f32x2* R = (LAS f32x2*)red + wr * 512;
#pragma unroll
    for (int ai = 0; ai < 2; ++ai)
#pragma unroll
        for (int m = 0; m < 4; ++m) { float s = 0.f, ss = 0.f;
#pragma unroll
            for (int bj = 0; bj < 2; ++bj) { const f32x4 va = acc[ai][bj][m][0], vb = acc[ai][bj][m][1];
                s += (va[0] + va[1]) + (va[2] + va[3]) + (vb[0] + vb[1]) + (vb[2] + vb[3]);
                ss += (va[0] * va[0] + va[1] * va[1]) + (va[2] * va[2] + va[3] * va[3]) + (vb[0] * vb[0] + vb[1] * vb[1]) + (vb[2] * vb[2] + vb[3] * vb[3]); }
            s += __shfl_xor(s, 16); s += __shfl_xor(s, 32); ss += __shfl_xor(ss, 16); ss += __shfl_xor(ss, 32);
            if (fq == 0) R[((ai * 4 + m) * 16 + fr) * 4 + wc] = (f32x2){s, ss}; }
    asm volatile("s_waitcnt lgkmcnt(0)" ::: "memory"); __builtin_amdgcn_s_barrier(); asm volatile("" ::: "memory");
    const int lane = fq * 16 + fr;
    if (lane < 32) { const int rl = wc * 32 + lane; const f32x2 a = R[rl * 4], b = R[rl * 4 + 1], c = R[rl * 4 + 2], d = R[rl * 4 + 3];
        const int ai = rl >> 6, m = (rl >> 4) & 3, f = rl & 15; const int row = u.pm * BM + ai * HALF + wr * 64 + m * 16 + f;
        *(f32x2*)(st + ((size_t)row * 4 + u.pn) * 2) = (f32x2){(a.x + b.x) + (c.x + d.x), (a.y + b.y) + (c.y + d.y)}; }
}
template <bool STATS, bool SRC32>
struct EpiRes {
    const float* src32; const bf16_t* srcX; const float* st_in; const float* gam; const float* bet; int ln; bf16_t* X; signed char* LO; float* st_out; LAS unsigned char* red;
    __device__ __forceinline__ void operator()(Acc& acc, const Unit& u, int wr, int wc, int fr, int fq) const {
        ROW_STATS8(st_in, (!SRC32), mu8, rs8);
        f32x4 ga[2], gb[2], ba[2], bb[2];
        BJLOOP { const int c0 = COL_OF(u, bj);
            if (ln) { ga[bj] = *(const f32x4*)(gam + c0); gb[bj] = *(const f32x4*)(gam + c0 + 4); ba[bj] = *(const f32x4*)(bet + c0); bb[bj] = *(const f32x4*)(bet + c0 + 4); } }
        if (SRC32) {
        ROWLOOP { const int row = ROW_OF(u, ai, m); float mu, rstd; row_stats(st_in, row, ln, mu, rstd);
            BJLOOP { const size_t off = (size_t)row * 1024 + COL_OF(u, bj);
                f32x4 ha = *(const f32x4*)(src32 + off), hb = *(const f32x4*)(src32 + off + 4);
                if (ln) { ha = (ha - mu) * rstd * ga[bj] + ba[bj]; hb = (hb - mu) * rstd * gb[bj] + bb[bj]; }
                acc[ai][bj][m][0] += ALPHA * ha; acc[ai][bj][m][1] += ALPHA * hb; }
            PIN(ai, m); FENCE2; }
        } else {
            u32x4 hi[2][2]; u32x2 lo[2][2];
#define RES_LOAD(r, s) do { const int row_ = ROW_OF(u, (r) >> 2, (r) & 3); \
                BJLOOP { const size_t off_ = (size_t)row_ * 1024 + COL_OF(u, bj); hi[s][bj] = *(const u32x4*)(srcX + off_); lo[s][bj] = *(const u32x2*)(LO + off_); } } while (0)
            RES_LOAD(0, 0);
#pragma unroll
            for (int r = 0; r < 8; ++r) {
                if (r + 1 < 8) RES_LOAD(r + 1, (r + 1) & 1);
                __builtin_amdgcn_sched_barrier(0);
                const int ai = r >> 2, m = r & 3, s = r & 1;
                const float mu = mu8[r], rstd = rs8[r];
                BJLOOP { f32x4 ha, hb; hl_decode(hi[s][bj], lo[s][bj], ha, hb);
                    ha = (ha - mu) * rstd * ga[bj] + ba[bj]; hb = (hb - mu) * rstd * gb[bj] + bb[bj];
                    acc[ai][bj][m][0] += ALPHA * ha; acc[ai][bj][m][1] += ALPHA * hb; }
                PIN(ai, m); asm volatile("" ::: "memory"); __builtin_amdgcn_sched_barrier(0);
            }
#undef RES_LOAD
        }
        asm volatile("" : "+v"(fr), "+v"(fq) :: "memory");
        ROWLOOP { const int row = ROW_OF(u, ai, m);
            BJLOOP { const size_t off = (size_t)row * 1024 + COL_OF(u, bj); hl_store(X, LO, off, acc[ai][bj][m][0], acc[ai][bj][m][1]); }
            FENCE1; }
        if (STATS) stats_publish(red, st_out, acc, u, wr, wc, fr, fq);
    }
};
struct EpiFfn {
    const float* st; const float* c1; const float* c2; bf16_t* HID;
    __device__ __forceinline__ void operator()(Acc& acc, const Unit& u, int wr, int wc, int fr, int fq) const {
        const int r0 = u.pn * 256 + wc * 32 + 8 * fq, hc = u.pn * 128 + wc * 32 + 8 * fq;
        ROW_STATS8(st, true, mu8, rs8);
        const f32x4 g1a = *(const f32x4*)(c1 + r0), g1b = *(const f32x4*)(c1 + r0 + 4), g2a = *(const f32x4*)(c2 + r0), g2b = *(const f32x4*)(c2 + r0 + 4);
        const f32x4 u1a = *(const f32x4*)(c1 + r0 + 128), u1b = *(const f32x4*)(c1 + r0 + 132), u2a = *(const f32x4*)(c2 + r0 + 128), u2b = *(const f32x4*)(c2 + r0 + 132);
        ROWLOOP { const float mu = mu8[ai * 4 + m], rstd = rs8[ai * 4 + m];
            f32x4 ga = (acc[ai][0][m][0] - mu * g1a) * rstd + g2a, gb = (acc[ai][0][m][1] - mu * g1b) * rstd + g2b;
            const f32x4 ua = (acc[ai][1][m][0] - mu * u1a) * rstd + u2a, ub = (acc[ai][1][m][1] - mu * u1b) * rstd + u2b;
#pragma unroll
            for (int j = 0; j < 4; ++j) { ga[j] = ga[j] * sigmoidf_(ga[j]) * ua[j]; gb[j] = gb[j] * sigmoidf_(gb[j]) * ub[j]; }
            acc[ai][0][m][0] = ga; acc[ai][0][m][1] = gb; PIN(ai, m); FENCE2; }
        asm volatile("" : "+v"(fr), "+v"(fq) :: "memory");
        ROWLOOP { const int row = ROW_OF(u, ai, m); *(u32x4*)(HID + (size_t)row * H_ + hc) = pack8(acc[ai][0][m][0], acc[ai][0][m][1]); FENCE2; }
    }
};
struct EpiPle {
    bf16_t* E;
    __device__ __forceinline__ void operator()(Acc& acc, const Unit& u, int wr, int wc, int fr, int fq) const {
        ROWLOOP { const int row = ROW_OF(u, ai, m);
            BJLOOP *(u32x4*)(E + (size_t)row * 1024 + COL_OF(u, bj)) = pack8(acc[ai][bj][m][0], acc[ai][bj][m][1]);
            FENCE2; }
    }
};
struct EpiGate {
    const bf16_t* E; const bf16_t* Xr; bf16_t* X; signed char* LO; float* st_out; LAS unsigned char* red;
    __device__ __forceinline__ void operator()(Acc& acc, const Unit& u, int wr, int wc, int fr, int fq) const {
        {
            u32x4 hi[2][2], ee[2][2]; u32x2 lo[2][2];
#define GATE_LOAD(r, s) do { const int row_ = ROW_OF(u, (r) >> 2, (r) & 3); \
                BJLOOP { const size_t off_ = (size_t)row_ * 1024 + COL_OF(u, bj); hi[s][bj] = *(const u32x4*)(Xr + off_); lo[s][bj] = *(const u32x2*)(LO + off_); ee[s][bj] = *(const u32x4*)(E + off_); } } while (0)
            GATE_LOAD(0, 0);
#pragma unroll
            for (int r = 0; r < 8; ++r) {
                if (r + 1 < 8) GATE_LOAD(r + 1, (r + 1) & 1);
                __builtin_amdgcn_sched_barrier(0);
                const int ai = r >> 2, m = r & 3, s = r & 1;
                BJLOOP { f32x4 ra, rb; hl_decode(hi[s][bj], lo[s][bj], ra, rb); f32x4 ea, eb; unpack8(ee[s][bj], ea, eb);
                    f32x4 va, vb;
#pragma unroll
                    for (int j = 0; j < 4; ++j) { va[j] = ra[j] + ea[j] * sigmoidf_(acc[ai][bj][m][0][j]); vb[j] = rb[j] + eb[j] * sigmoidf_(acc[ai][bj][m][1][j]); }
                    acc[ai][bj][m][0] = va; acc[ai][bj][m][1] = vb; }
                PIN(ai, m); asm volatile("" ::: "memory"); __builtin_amdgcn_sched_barrier(0);
            }
#undef GATE_LOAD
        }
        asm volatile("" : "+v"(fr), "+v"(fq) :: "memory");
        ROWLOOP { const int row = ROW_OF(u, ai, m);
            BJLOOP { const size_t off = (size_t)row * 1024 + COL_OF(u, bj); hl_store(X, LO, off, acc[ai][bj][m][0], acc[ai][bj][m][1]); }
            FENCE1; }
        stats_publish(red, st_out, acc, u, wr, wc, fr, fq);
    }
};

__device__ void transpose_job(float* tile  , const float* src, int lds_, int K, int N, const float* scale, bf16_t* dst, int mode, int off, int& base,
                              const float* bet = nullptr, float* c1 = nullptr, float* c2 = nullptr, int coff = 0) {
    const int tid = threadIdx.x, G = gridDim.x, nkt = K / 64, nnt = N / 64, ntile = nkt * nnt;
    int first = ((int)blockIdx.x - base) % G; if (first < 0) first += G;
    for (int t = first; t < ntile; t += G) {
        const int kt = t / nnt, ntl = t % nnt;
        __syncthreads();
#pragma unroll
        for (int pss = 0; pss < 2; ++pss) { const int kk = pss * 32 + (tid >> 4), n4 = (tid & 15) * 4;
            const f32x4 v = *(const f32x4*)(src + (size_t)(kt * 64 + kk) * lds_ + ntl * 64 + n4);
            tile[(n4 + 0) * 65 + kk] = v[0]; tile[(n4 + 1) * 65 + kk] = v[1]; tile[(n4 + 2) * 65 + kk] = v[2]; tile[(n4 + 3) * 65 + kk] = v[3]; }
        __syncthreads();
        { const int n = tid >> 3, k8 = (tid & 7) * 8; const float* r = tile + n * 65 + k8;
            float sc[8];
#pragma unroll
            for (int j = 0; j < 8; ++j) sc[j] = scale ? scale[kt * 64 + k8 + j] : 1.0f;
            u32x4 w; w.x = cvt_pk(r[0] * sc[0], r[1] * sc[1]); w.y = cvt_pk(r[2] * sc[2], r[3] * sc[3]); w.z = cvt_pk(r[4] * sc[4], r[5] * sc[5]); w.w = cvt_pk(r[6] * sc[6], r[7] * sc[7]);
            const int ng = ntl * 64 + n; const int drow = mode ? ((ng >> 7) * 256 + (ng & 127) + off) : ng;
            *(u32x4*)(dst + (size_t)drow * K + kt * 64 + k8) = w;
            if (c1) {
                float s1 = (bflo(w.x) + bfhi(w.x)) + (bflo(w.y) + bfhi(w.y)) + (bflo(w.z) + bfhi(w.z)) + (bflo(w.w) + bfhi(w.w)), s2 = 0.f;
#pragma unroll
                for (int j = 0; j < 8; ++j) s2 += r[j] * bet[kt * 64 + k8 + j];
                s1 += __shfl_xor(s1, 1); s1 += __shfl_xor(s1, 2); s1 += __shfl_xor(s1, 4); s2 += __shfl_xor(s2, 1); s2 += __shfl_xor(s2, 2); s2 += __shfl_xor(s2, 4);
                if ((tid & 7) == 0) { atomicAdd(c1 + coff + drow, s1); atomicAdd(c2 + coff + drow, s2); } }
        }
    }
    base = (base + ntile) % G;
}

template <int W>
__device__ __forceinline__ void fir_item(const bf16_t* __restrict__ qb, bf16_t* __restrict__ mb, int t0, const f32x4 ba, const f32x4 bb, const f32x4 sa, const f32x4 sb) {
    constexpr int TS = 8, NR = W - 1 + TS;
    u32x4 raw[NR];
#pragma unroll
    for (int r = 0; r < NR; ++r) { const int t = t0 - (W - 1) + r; raw[r] = (t >= 0) ? *(const u32x4*)(qb + (size_t)t * 512) : (u32x4){0u, 0u, 0u, 0u}; }
    f32x4 sma = {0.f, 0.f, 0.f, 0.f}, smb = sma;
#pragma unroll
    for (int r = 0; r < W - 1; ++r) { f32x4 a, c; unpack8(raw[r], a, c); sma += a; smb += c; }
#pragma unroll
    for (int j = 0; j < TS; ++j) { const int t = t0 + j; f32x4 a, c; unpack8(raw[W - 1 + j], a, c); sma += a; smb += c;
        const float inv = 1.0f / (float)((t + 1) < W ? (t + 1) : W);
        *(u32x4*)(mb + (size_t)t * 1024) = pack8((sma * inv - a + ba) * sa, (smb * inv - c + bb) * sb);
        f32x4 a2, c2; unpack8(raw[j], a2, c2); sma -= a2; smb -= c2; }
}
__device__ __forceinline__ int bx_() { int b = blockIdx.x; asm volatile("" : "+s"(b)); return b; }
__global__ void __launch_bounds__(512, 2) fwd_megakernel(Params p) {
    extern __shared__ __attribute__((aligned(16))) unsigned char lds_raw[];
    LAS unsigned char* lds = (LAS unsigned char*)lds_raw;
    cg::grid_group grid = cg::this_grid();
    const int G = gridDim.x;
    { volatile LAS unsigned* xst = (volatile LAS unsigned*)(lds + 136 * 1024); if (threadIdx.x == 0) { xst[0] = 0u; xst[1] = 0u; } __syncthreads(); (void)xcd_barrier_post((unsigned*)(p.ws + WS_BAR), xst); }
#define GRID_BAR() do { XcdBarrier xb_; xb_.bar = (unsigned*)(p.ws + WS_BAR); xb_.x = xb_xcc_id(); xb_.st = (volatile LAS unsigned*)(lds + 136 * 1024); xcd_barrier(xb_); } while (0)
#define FRESH_TID() int tid = threadIdx.x; asm volatile("" : "+v"(tid)); const size_t gtid = (size_t)blockIdx.x * 512 + tid, gsz = (size_t)G * 512; (void)gsz; (void)gtid;
    unsigned char* ws = p.ws;
    const float* x = p.in[0]; const float* pin = p.in[1];
    bf16_t* X1 = (bf16_t*)(ws + WS_X1); bf16_t* X2 = (bf16_t*)(ws + WS_X2); bf16_t* PB = (bf16_t*)p.out;
    signed char* LO = (signed char*)(ws + WS_PB);
    float* STATS = (float*)(ws + WS_STATS2); float* LBP = (float*)(ws + WS_LBP); float* BBAR = (float*)(ws + WS_BBAR); float* KMAT = (float*)(ws + WS_KMAT);
    bf16_t* PG = (bf16_t*)(ws + WS_PG); float* LOC = (float*)(ws + WS_LOC); bf16_t* BAUG = (bf16_t*)(ws + WS_BAUG);
    float* WCOMB = (float*)(ws + WS_WCOMB); float* CVEC = (float*)(ws + WS_CVEC);
    bf16_t* AAUG = (bf16_t*)(ws + WS_BIG + BIG_AAUG); bf16_t* Q = (bf16_t*)(ws + WS_BIG + BIG_Q); bf16_t* YG = (bf16_t*)(ws + WS_BIG + BIG_YG);
    bf16_t* MIX = (bf16_t*)(ws + WS_BIG + BIG_MIX); bf16_t* HID = (bf16_t*)(ws + WS_BIG); bf16_t* EB = (bf16_t*)((unsigned char*)p.out + 128 * MiB);

    { FRESH_TID();
    for (size_t i = gtid; i < (size_t)NL_ * CVEC_PER_LAYER; i += gsz) CVEC[i] = 0.f;
    for (size_t i = gtid; i < (size_t)T_ * D_ / 8; i += gsz) { const f32x4 a = ((const f32x4*)x)[2 * i], b = ((const f32x4*)x)[2 * i + 1]; ((u32x4*)X1)[i] = pack8(a, b); }
    for (size_t i = gtid; i < (size_t)NL_ * T_ * PLE_ / 8; i += gsz) { const f32x4 a = ((const f32x4*)pin)[2 * i], b = ((const f32x4*)pin)[2 * i + 1]; ((u32x4*)PB)[i] = pack8(a, b); }
    for (size_t it = gtid; it < (size_t)NL_ * 32 * 64 * 66; it += gsz) {
        const int i = (int)(it / 66), k = (int)(it % 66), lg = i >> 6;
        const double ar = fmin((double)p.in[6][i], -1e-4), aim = (double)p.in[7][i], dt = exp((double)p.in[8][lg]);
        if (k <= 64) { const double mag = exp(ar * dt * k), ang = aim * dt * k; LBP[((size_t)i * 65 + k) * 2] = (float)(mag * cos(ang)); LBP[((size_t)i * 65 + k) * 2 + 1] = (float)(mag * sin(ang)); }
        else { const double mag = exp(ar * dt), ang = aim * dt; const double nr = mag * cos(ang) - 1.0, ni = mag * sin(ang), den = ar * ar + aim * aim;
            const double qr = (nr * ar + ni * aim) / den, qi = (ni * ar - nr * aim) / den;
            for (int c = 0; c < 16; ++c) { const double br = (double)p.in[9][(size_t)i * 16 + c], bi = (double)p.in[10][(size_t)i * 16 + c];
                BBAR[((size_t)i * 16 + c) * 2] = (float)(qr * br - qi * bi); BBAR[((size_t)i * 16 + c) * 2 + 1] = (float)(qr * bi + qi * br); } }
    }
    for (size_t i = gtid; i < (size_t)NL_ * 1024 * 512; i += gsz) {
        const int d = (int)(i & 127), gp = (int)((i >> 7) & 3), k = (int)((i >> 9) & 1023), l = (int)(i >> 19);
        const float* wi = p.in[2] + ((size_t)l * 1024 + k) * 1024 + gp * 128; const float* wp = p.in[3] + ((size_t)(l * 4 + gp) * 128) * 128 + d;
        float s = 0.f;
        for (int c = 0; c < 128; ++c) s += wi[c] * wp[(size_t)c * 128];
        WCOMB[i] = s;
    }
    }
    if (gridDim.x == 0x7fffffffu) grid.sync();
    GRID_BAR();

    { FRESH_TID();
    for (size_t i = gtid; i < (size_t)NL_ * 32 * 64 * 16; i += gsz) {
        const int c = (int)(i & 15), lag = (int)((i >> 4) & 63), lg = (int)(i >> 10);
        const float* cre = p.in[11] + ((size_t)lg * 16 + c) * 64; const float* cim = p.in[12] + ((size_t)lg * 16 + c) * 64;
        f32x4 s0 = {0.f, 0.f, 0.f, 0.f}, s1 = s0, s2 = s0, s3 = s0;
        for (int n = 0; n < 64; ++n) { const size_t sn = (size_t)lg * 64 + n; const f32x2 pw = *(const f32x2*)(LBP + (sn * 65 + lag) * 2);
            const float er = cre[n] * pw.x - cim[n] * pw.y, ei = cre[n] * pw.y + cim[n] * pw.x;
            const f32x4* bb = (const f32x4*)(BBAR + sn * 32);
#pragma unroll
            for (int q = 0; q < 8; ++q) { const f32x4 b = bb[q]; const float v0 = er * b[0] - ei * b[1], v1 = er * b[2] - ei * b[3];
                if (q < 2) { s0[(q & 1) * 2] += v0; s0[(q & 1) * 2 + 1] += v1; } else if (q < 4) { s1[(q & 1) * 2] += v0; s1[(q & 1) * 2 + 1] += v1; }
                else if (q < 6) { s2[(q & 1) * 2] += v0; s2[(q & 1) * 2 + 1] += v1; } else { s3[(q & 1) * 2] += v0; s3[(q & 1) * 2 + 1] += v1; } } }
        f32x4* dst = (f32x4*)(KMAT + i * 16); dst[0] = s0; dst[1] = s1; dst[2] = s2; dst[3] = s3;
    }
    for (size_t i = gtid; i < (size_t)NL_ * 32 * 128 * 128; i += gsz) {
        const int v = (int)(i & 127), nri = (int)((i >> 7) & 127), lg = (int)(i >> 14); const int sl = v >> 1, c0 = (v & 1) * 8, n = nri >> 1, ri = nri & 1;
        const size_t sn = (size_t)lg * 64 + n; const float pr = LBP[(sn * 65 + (63 - sl)) * 2], pi = LBP[(sn * 65 + (63 - sl)) * 2 + 1];
        float o[8];
#pragma unroll
        for (int j = 0; j < 8; ++j) { const float br = BBAR[(sn * 16 + c0 + j) * 2], bi = BBAR[(sn * 16 + c0 + j) * 2 + 1]; o[j] = ri ? (pr * bi + pi * br) : (pr * br - pi * bi); }
        u32x4 w; w.x = cvt_pk(o[0], o[1]); w.y = cvt_pk(o[2], o[3]); w.z = cvt_pk(o[4], o[5]); w.w = cvt_pk(o[6], o[7]);
        *(u32x4*)(PG + ((size_t)lg * 128 + nri) * 1024 + sl * 16 + c0) = w;
    }
    {
        float* tile = (float*)lds_raw; int base = 0;
        for (int l = 0; l < NL_; ++l) {
            const float* g2p = l ? p.in[24] + (size_t)(l - 1) * 1024 : nullptr; const float* g1 = p.in[17] + (size_t)l * 1024;
            bf16_t* WIN = (bf16_t*)(ws + WS_WIN) + (size_t)l * 1024 * 1024;
            const float* b2p = l ? p.in[25] + (size_t)(l - 1) * 1024 : nullptr; const float* b1 = p.in[18] + (size_t)l * 1024; float* cvl = CVEC + (size_t)l * CVEC_PER_LAYER;
            transpose_job(tile, WCOMB + (size_t)l * 1024 * 512, 512, 1024, 512, g2p, WIN, 0, 0, base, b2p, l ? cvl : nullptr, cvl + 1024, 0);
            transpose_job(tile, p.in[2] + (size_t)l * 1024 * 1024 + 512, 1024, 1024, 512, g2p, WIN + (size_t)512 * 1024, 0, 0, base, b2p, l ? cvl : nullptr, cvl + 1024, 512);
            transpose_job(tile, p.in[16] + (size_t)l * 1024 * 1024, 1024, 1024, 1024, nullptr, (bf16_t*)(ws + WS_WOUT) + (size_t)l * 1024 * 1024, 0, 0, base);
            transpose_job(tile, p.in[23] + (size_t)l * 1024 * 1024, 1024, 1024, 1024, nullptr, (bf16_t*)(ws + WS_GATE) + (size_t)l * 1024 * 1024, 0, 0, base);
            transpose_job(tile, p.in[14] + (size_t)l * 512 * 512, 512, 512, 512, nullptr, (bf16_t*)(ws + WS_GLU) + (size_t)l * 512 * 512, 0, 0, base);
            transpose_job(tile, p.in[22] + (size_t)l * 256 * 1024, 1024, 256, 1024, nullptr, (bf16_t*)(ws + WS_PLE) + (size_t)l * 1024 * 256, 0, 0, base);
            transpose_job(tile, p.in[19] + (size_t)l * 1024 * H_, H_, 1024, H_, g1, (bf16_t*)(ws + WS_W13) + (size_t)l * 5632 * 1024, 1, 0, base, b1, cvl + 2048, cvl + 2048 + 5632, 0);
            transpose_job(tile, p.in[20] + (size_t)l * 1024 * H_, H_, 1024, H_, g1, (bf16_t*)(ws + WS_W13) + (size_t)l * 5632 * 1024, 1, 128, base, b1, cvl + 2048, cvl + 2048 + 5632, 0);
            transpose_job(tile, p.in[21] + (size_t)l * H_ * 1024, 1024, H_, 1024, nullptr, (bf16_t*)(ws + WS_W2) + (size_t)l * 1024 * H_, 0, 0, base);
        }
        __syncthreads();
    }
    }
    GRID_BAR();

    for (int l = 0; l < NL_; ++l) {
        const float* cv = CVEC + (size_t)l * CVEC_PER_LAYER;
        float* st1 = STATS + (size_t)(2 * l) * T_ * 8; float* st2 = STATS + (size_t)(2 * l + 1) * T_ * 8;
        const float* st2p = l ? STATS + (size_t)(2 * l - 1) * T_ * 8 : STATS;
        { Gemm g{X1, (const bf16_t*)(ws + WS_WIN) + (size_t)l * 1024 * 1024, 1024, 1024, 1024, 0, 0, 0}; Sched S; S.init(T_, 1024, 1, G, bx_());
          EpiIn E{st2p, cv, cv + 1024, Q, AAUG, l > 0}; gemm_phase(lds, g, S, E); }
        GRID_BAR();
        { Gemm g{AAUG, PG + (size_t)l * 32 * 128 * 1024, 1152, 1024, 1024, (size_t)1024 * 1152 * 2, (size_t)128 * 1024 * 2, 1}; Sched S; S.init(1024, 256, 32, G, bx_());
          EpiLoc E{LOC}; gemm_phase(lds, g, S, E);
          Unit u;
          if (S.next(0, u)) {
              FRESH_TID();
              __threadfence(); __syncthreads();
              const int bl = tid >> 6, n = tid & 63; const size_t sn = ((size_t)l * 32 + u.g) * 64 + n;
              const float ar = LBP[(sn * 65 + 64) * 2], ai_ = LBP[(sn * 65 + 64) * 2 + 1];
              float sr = 0.f, si = 0.f;
              const size_t row0 = (size_t)u.g * 1024 + u.pm * 256 + bl * 32;
              for (int j0 = 0; j0 < 32; j0 += 8) {
                  f32x2 lc[8];
#pragma unroll
                  for (int j = 0; j < 8; ++j) lc[j] = *(const f32x2*)(LOC + (row0 + j0 + j) * 128 + 2 * n);
#pragma unroll
                  for (int j = 0; j < 8; ++j) { *(unsigned*)(AAUG + (row0 + j0 + j) * 1152 + 1024 + 2 * n) = cvt_pk(sr, si);
                      const float nr = ar * sr - ai_ * si + lc[j].x, ni = ar * si + ai_ * sr + lc[j].y; sr = nr; si = ni; }
              }
          }
        }
        {
            FRESH_TID();
            for (size_t it = gtid; it < (size_t)32 * 256 * 64; it += gsz) {
                const int c16 = (int)(it & 15), tch = (int)((it >> 4) & 255), grp = (int)((it >> 12) & 3), b = (int)(it >> 14); const int cvv = grp * 16 + c16, t0 = tch * 8;
                const bf16_t* qb = Q + (size_t)b * SEQ_ * 512 + cvv * 8; bf16_t* mb = MIX + (size_t)b * SEQ_ * 1024 + cvv * 8;
                const float* pb = p.in[4] + (size_t)l * 512 + cvv * 8; const float* ps = p.in[5] + (size_t)l * 512 + cvv * 8;
                const f32x4 ba = *(const f32x4*)pb, bb = *(const f32x4*)(pb + 4), sa = *(const f32x4*)ps, sb = *(const f32x4*)(ps + 4);
                if (grp == 0) fir_item<2>(qb, mb, t0, ba, bb, sa, sb); else if (grp == 1) fir_item<4>(qb, mb, t0, ba, bb, sa, sb);
                else if (grp == 2) fir_item<8>(qb, mb, t0, ba, bb, sa, sb); else fir_item<16>(qb, mb, t0, ba, bb, sa, sb);
            }
        }
        const int nsw = G, swi = (int)blockIdx.x;
        { FRESH_TID();
        const float* kmat_l = KMAT + (size_t)l * 32 * 64 * 256;
        for (size_t i0 = gtid; i0 < (size_t)32 * 1024 * 128; i0 += 4 * gsz) {
            f32x4 a[4], b[4]; bool nz[4];
#pragma unroll
            for (int j = 0; j < 4; ++j) { const size_t i = i0 + j * gsz; const int kv = (int)(i & 127), rowi = (int)((i >> 7) & 1023), gg = (int)(i >> 17); const int tl = rowi >> 4, c = rowi & 15, sl = kv >> 1, c0 = (kv & 1) * 8;
                nz[j] = (i < (size_t)32 * 1024 * 128) && (sl <= tl);
                if (nz[j]) { const float* km = kmat_l + ((((size_t)gg * 64 + (tl - sl)) * 16 + c) * 16 + c0); a[j] = *(const f32x4*)km; b[j] = *(const f32x4*)(km + 4); }
                else { a[j] = (f32x4){0.f, 0.f, 0.f, 0.f}; b[j] = a[j]; } }
#pragma unroll
            for (int j = 0; j < 4; ++j) { const size_t i = i0 + j * gsz; if (i < (size_t)32 * 1024 * 128) { const int kv = (int)(i & 127); const size_t grow = i >> 7;
                *(u32x4*)(BAUG + grow * 1152 + kv * 8) = pack8(a[j], b[j]); } }
        }
        for (size_t i = gtid; i < (size_t)32 * 1024 * 16; i += gsz) {
            const int kv = (int)(i & 15), rowi = (int)((i >> 4) & 1023), gg = (int)(i >> 14); const int tl = rowi >> 4, c = rowi & 15, n0 = kv * 4; const size_t lg = (size_t)l * 32 + gg;
            const f32x4 cr = *(const f32x4*)(p.in[11] + (lg * 16 + c) * 64 + n0), ci = *(const f32x4*)(p.in[12] + (lg * 16 + c) * 64 + n0);
            float o[8];
#pragma unroll
            for (int j = 0; j < 4; ++j) { const f32x2 pw = *(const f32x2*)(LBP + ((lg * 64 + n0 + j) * 65 + tl + 1) * 2); o[2 * j] = cr[j] * pw.x - ci[j] * pw.y; o[2 * j + 1] = -(cr[j] * pw.y + ci[j] * pw.x); }
            u32x4 w; w.x = cvt_pk(o[0], o[1]); w.y = cvt_pk(o[2], o[3]); w.z = cvt_pk(o[4], o[5]); w.w = cvt_pk(o[6], o[7]);
            *(u32x4*)(BAUG + ((size_t)gg * 1024 + rowi) * 1152 + 1024 + kv * 8) = w;
        }
        }
        GRID_BAR();
        { Gemm g{AAUG, BAUG, 1152, 1152, 1152, (size_t)1024 * 1152 * 2, (size_t)1024 * 1152 * 2, 0}; Sched S; S.init(1024, 1024, 32, G, bx_());
          EpiSsm E{AAUG, p.in[13] + (size_t)l * 512, YG}; gemm_phase(lds, g, S, E); }
        GRID_BAR();
        { Gemm g{YG, (const bf16_t*)(ws + WS_GLU) + (size_t)l * 512 * 512, 512, 512, 512, 0, 0, 0}; Sched S; S.init(T_, 512, 1, G, bx_());
          EpiGlu E{YG, p.in[15] + (size_t)l * 512, MIX}; gemm_phase(lds, g, S, E); }
        GRID_BAR();
        { Gemm g{MIX, (const bf16_t*)(ws + WS_WOUT) + (size_t)l * 1024 * 1024, 1024, 1024, 1024, 0, 0, 0}; Sched S; S.init(T_, 1024, 1, G, bx_());
          if (l == 0) { EpiRes<true, true> E{x, nullptr, st2p, x, x, 0, X1, LO, st1, lds + 128 * 1024}; gemm_phase(lds, g, S, E); }
          else { EpiRes<true, false> E{nullptr, X1, st2p, p.in[24] + (size_t)(l - 1) * 1024, p.in[25] + (size_t)(l - 1) * 1024, 1, X1, LO, st1, lds + 128 * 1024}; gemm_phase(lds, g, S, E); } }
        GRID_BAR();
        { Gemm g{X1, (const bf16_t*)(ws + WS_W13) + (size_t)l * 5632 * 1024, 1024, 1024, 1024, 0, 0, 0}; Sched S; S.init(T_, 5632, 1, G, bx_());
          EpiFfn E{st1, cv + 2048, cv + 2048 + 5632, HID}; gemm_phase(lds, g, S, E); }
        GRID_BAR();
        { const int ple_first = (bx_() >> 3) & 1;
          for (int step = 0; step < 2; ++step) {
            if ((step == 0) == (ple_first != 0)) {
              Gemm g{PB + (size_t)l * T_ * PLE_, (const bf16_t*)(ws + WS_PLE) + (size_t)l * 1024 * 256, 256, 256, 256, 0, 0, 0}; Sched S; S.init(T_, 1024, 1, G, bx_());
              EpiPle E{EB}; gemm_phase(lds, g, S, E);
            } else {
              Gemm g{HID, (const bf16_t*)(ws + WS_W2) + (size_t)l * 1024 * H_, H_, H_, H_, 0, 0, 0}; Sched S; S.init(T_, 1024, 1, G, bx_());
              EpiRes<false, false> E{nullptr, X1, st1, p.in[17] + (size_t)l * 1024, p.in[18] + (size_t)l * 1024, 1, X2, LO, nullptr, lds + 128 * 1024}; gemm_phase(lds, g, S, E);
            }
          } }
        GRID_BAR();
        { Gemm g{X2, (const bf16_t*)(ws + WS_GATE) + (size_t)l * 1024 * 1024, 1024, 1024, 1024, 0, 0, 0}; Sched S; S.init(T_, 1024, 1, G, bx_());
          EpiGate E{EB, X2, X1, LO, st2, lds + 128 * 1024}; gemm_phase(lds, g, S, E); }
        GRID_BAR();
    }
    {
        FRESH_TID();
        const float* st = STATS + (size_t)(2 * NL_ - 1) * T_ * 8; const float* gam = p.in[24] + (size_t)(NL_ - 1) * 1024; const float* bet = p.in[25] + (size_t)(NL_ - 1) * 1024;
        for (size_t i = gtid; i < (size_t)T_ * D_ / 8; i += gsz) { const int row = (int)(i >> 7), c = (int)(i & 127) * 8; float mu, rstd; row_stats(st, row, true, mu, rstd);
            f32x4 va, vb; hl_load(X1, LO, i * 8, va, vb);
            ((f32x4*)p.out)[2 * i] = (va - mu) * rstd * *(const f32x4*)(gam + c) + *(const f32x4*)(bet + c);
            ((f32x4*)p.out)[2 * i + 1] = (vb - mu) * rstd * *(const f32x4*)(gam + c + 4) + *(const f32x4*)(bet + c + 4); }
    }
}

extern "C" void kernel_launch(void* const* d_in, const int* in_sizes, int n_in, void* d_out, int out_size, void* d_ws, size_t ws_size, hipStream_t stream) {
    static int grid = 0;
    if (!grid) {
        int dev = 0, cus = 0, per_cu = 0;
        (void)hipGetDevice(&dev);
        (void)hipDeviceGetAttribute(&cus, hipDeviceAttributeMultiprocessorCount, dev);
        if (hipFuncSetAttribute((const void*)fwd_megakernel, hipFuncAttributeMaxDynamicSharedMemorySize, LDS_BYTES) != hipSuccess) fprintf(stderr, "hipFuncSetAttribute failed\n");
        (void)hipOccupancyMaxActiveBlocksPerMultiprocessor(&per_cu, (const void*)fwd_megakernel, 512, LDS_BYTES);
        if (per_cu < 1) fprintf(stderr, "occupancy query says %d blocks per CU\n", per_cu);
        if (ws_size < WS_END || n_in != 26 || out_size != T_ * D_) fprintf(stderr, "unexpected sizes: ws %zu n_in %d out %d\n", ws_size, n_in, out_size);
        grid = cus > 0 ? cus : 256;
    }
    if (hipMemsetAsync((unsigned char*)d_ws + WS_BAR, 0, XCD_BAR_WORDS * 4, stream) != hipSuccess) fprintf(stderr, "memset of the barrier words failed\n");
    Params p{};
    for (int i = 0; i < 26; ++i) p.in[i] = (const float*)d_in[i];
    p.out = (float*)d_out; p.ws = (unsigned char*)d_ws;
    void* args[] = {&p};
    hipError_t e = hipLaunchCooperativeKernel((const void*)fwd_megakernel, dim3(grid), dim3(512), args, LDS_BYTES, stream);
    if (e != hipSuccess) fprintf(stderr, "cooperative launch failed: %s (grid %d)\n", hipGetErrorString(e), grid);
}
```

```cpp
#include <hip/hip_runtime.h>
#include <hip/hip_cooperative_groups.h>
#include <cstdio>
namespace cg = cooperative_groups;

#define LAS __attribute__((address_space(3)))
typedef unsigned short bf16_t;
typedef short bf16x8 __attribute__((ext_vector_type(8)));
typedef float f32x4 __attribute__((ext_vector_type(4)));
typedef float f32x2 __attribute__((ext_vector_type(2)));
typedef unsigned u32x4 __attribute__((ext_vector_type(4)));

constexpr int T_ = 65536, D_ = 1024, H_ = 2816, NL_ = 4, SEQ_ = 2048, PLE_ = 256;
constexpr float ALPHA = 1.6817928305074290f;
constexpr float LN_EPS = 1e-5f;
constexpr int LDS_BYTES = 144 * 1024;

constexpr size_t MiB = (size_t)1 << 20;
constexpr size_t WS_WIN = 0, WS_WOUT = 8 * MiB, WS_GATE = 16 * MiB, WS_GLU = 24 * MiB, WS_PLE = 26 * MiB, WS_W13 = 28 * MiB, WS_W2 = 72 * MiB,
                 WS_WCOMB = 94 * MiB, WS_CVEC = 102 * MiB, WS_STATS = 103 * MiB, WS_LBP = 107 * MiB, WS_BBAR = 112 * MiB, WS_KMAT = 113 * MiB,
                 WS_PG = 121 * MiB, WS_LOC = 153 * MiB, WS_BAUG = 169 * MiB, WS_X1 = 241 * MiB, WS_X2 = 369 * MiB, WS_PB = 497 * MiB, WS_BIG = 625 * MiB,
                 WS_STATS2 = 977 * MiB, WS_END = 993 * MiB;
constexpr size_t BIG_AAUG = 0, BIG_Q = 72 * MiB, BIG_YG = 136 * MiB, BIG_MIX = 200 * MiB, BIG_E = 0;
constexpr size_t WS_BAR = WS_CVEC + 768 * 1024;
constexpr int CVEC_PER_LAYER = 2 * 1024 + 2 * 5632;

struct Params { const float* in[26]; float* out; unsigned char* ws; };

__device__ __forceinline__ bf16_t f2bf(float f) { unsigned u = __float_as_uint(f); u += 0x7FFFu + ((u >> 16) & 1u); return (bf16_t)(u >> 16); }
__device__ __forceinline__ float bf2f(bf16_t b) { return __uint_as_float(((unsigned)b) << 16); }
__device__ __forceinline__ unsigned cvt_pk(float lo, float hi) { unsigned r; asm volatile("v_cvt_pk_bf16_f32 %0, %1, %2" : "=v"(r) : "v"(lo), "v"(hi)); return r; }
__device__ __forceinline__ float bflo(unsigned w) { return __uint_as_float(w << 16); }
__device__ __forceinline__ float bfhi(unsigned w) { return __uint_as_float(w & 0xffff0000u); }
__device__ __forceinline__ u32x4 pack8(const f32x4 a, const f32x4 b) { u32x4 w; w.x = cvt_pk(a[0], a[1]); w.y = cvt_pk(a[2], a[3]); w.z = cvt_pk(b[0], b[1]); w.w = cvt_pk(b[2], b[3]); return w; }
__device__ __forceinline__ void unpack8(const u32x4 w, f32x4& a, f32x4& b) { a = (f32x4){bflo(w.x), bfhi(w.x), bflo(w.y), bfhi(w.y)}; b = (f32x4){bflo(w.z), bfhi(w.z), bflo(w.w), bfhi(w.w)}; }
typedef unsigned u32x2 __attribute__((ext_vector_type(2)));
__device__ __forceinline__ void hl_pack(const f32x4 va, const f32x4 vb, u32x4& w, u32x2& l) {
    const unsigned t0 = __float_as_uint(va[0]) + 0x8000u, t1 = __float_as_uint(va[1]) + 0x8000u, t2 = __float_as_uint(va[2]) + 0x8000u, t3 = __float_as_uint(va[3]) + 0x8000u;
    const unsigned t4 = __float_as_uint(vb[0]) + 0x8000u, t5 = __float_as_uint(vb[1]) + 0x8000u, t6 = __float_as_uint(vb[2]) + 0x8000u, t7 = __float_as_uint(vb[3]) + 0x8000u;
    w.x = __builtin_amdgcn_perm(t1, t0, 0x07060302u); w.y = __builtin_amdgcn_perm(t3, t2, 0x07060302u); w.z = __builtin_amdgcn_perm(t5, t4, 0x07060302u); w.w = __builtin_amdgcn_perm(t7, t6, 0x07060302u);
    l.x = __builtin_amdgcn_perm(t1, t0, 0x0c0c0501u) | __builtin_amdgcn_perm(t3, t2, 0x05010c0cu); l.y = __builtin_amdgcn_perm(t5, t4, 0x0c0c0501u) | __builtin_amdgcn_perm(t7, t6, 0x05010c0cu);
}
__device__ __forceinline__ size_t lo_off(int row, int pn, int wc, int fq) { return ((((size_t)row * 4 + pn) * 4 + wc) * 4 + fq) * 16; }
__device__ __forceinline__ void hl_decode(const u32x4 w, const u32x2 l, f32x4& va, f32x4& vb) {
    va[0] = __uint_as_float(__builtin_amdgcn_perm(w.x, l.x, 0x0504000cu) - 0x7f80u); va[1] = __uint_as_float(__builtin_amdgcn_perm(w.x, l.x, 0x0706010cu) - 0x7f80u);
    va[2] = __uint_as_float(__builtin_amdgcn_perm(w.y, l.x, 0x0504020cu) - 0x7f80u); va[3] = __uint_as_float(__builtin_amdgcn_perm(w.y, l.x, 0x0706030cu) - 0x7f80u);
    vb[0] = __uint_as_float(__builtin_amdgcn_perm(w.z, l.y, 0x0504000cu) - 0x7f80u); vb[1] = __uint_as_float(__builtin_amdgcn_perm(w.z, l.y, 0x0706010cu) - 0x7f80u);
    vb[2] = __uint_as_float(__builtin_amdgcn_perm(w.w, l.y, 0x0504020cu) - 0x7f80u); vb[3] = __uint_as_float(__builtin_amdgcn_perm(w.w, l.y, 0x0706030cu) - 0x7f80u);
}
__device__ __forceinline__ void hl_load(const bf16_t* X, const signed char* LO, int row, int col, f32x4& va, f32x4& vb) { const int c = col & 255;
    hl_decode(*(const u32x4*)(X + (size_t)row * 1024 + col), *(const u32x2*)(LO + lo_off(row, col >> 8, (c >> 5) & 3, (c >> 3) & 3) + (c >> 7) * 8), va, vb); }
__device__ __forceinline__ float sigmoidf_(float v) { return __builtin_amdgcn_rcpf(1.0f + __expf(-v)); }
__device__ __forceinline__ float gelu_tanh(float y) { const float z = 1.5957691216057308f * (y + 0.044715f * y * y * y); return y * sigmoidf_(z); }

#define XB_TMO      128
#define XB_XCNT(j)  (256  + 64 * (j))
#define XB_XSUB(j)  (1280 + 64 * (j))
#define XB_XGEN(j)  (2304 + 64 * (j))
#define XB_TOP      3328
#define XB_TOPGEN   3392
#define XCD_BAR_WORDS 3456
#define XB_SPIN_CAP (1u << 18)
__device__ __forceinline__ unsigned xb_ld(unsigned* p)              { return __hip_atomic_load(p, __ATOMIC_RELAXED, __HIP_MEMORY_SCOPE_AGENT); }
__device__ __forceinline__ unsigned xb_add(unsigned* p, unsigned v) { return __hip_atomic_fetch_add(p, v, __ATOMIC_RELAXED, __HIP_MEMORY_SCOPE_AGENT); }
__device__ __forceinline__ unsigned xb_xcc_id() { return (unsigned)__builtin_amdgcn_s_getreg((3 << 11) | 20) & 0xFu; }
#define XB_SPIN(cond, bar) do { unsigned _sp = 0; while (cond) { __builtin_amdgcn_s_sleep(1); \
    if ((++_sp & 255u) == 0u) { if (xb_ld(&(bar)[XB_TMO])) break; if (_sp > XB_SPIN_CAP) { atomicAdd(&(bar)[XB_TMO], 1u); break; } } } } while (0)
struct XcdBarrier { unsigned* bar; unsigned x; volatile LAS unsigned* st; };
__device__ __forceinline__ XcdBarrier xcd_barrier_post(unsigned* bar, volatile LAS unsigned* st) {
    XcdBarrier b; b.bar = bar; b.x = xb_xcc_id(); b.st = st;
    if (threadIdx.x == 0) (void)xb_add(&bar[XB_XCNT(b.x)], 1u);
    return b;
}
__device__ __forceinline__ void xcd_barrier_complete(unsigned* bar, unsigned x, unsigned& nloc, unsigned& nx) {
    const unsigned G = gridDim.x * gridDim.y * gridDim.z;
    unsigned sum, cnt, mine, sp = 0u;
    for (;;) {
        sum = 0u; cnt = 0u; mine = 0u;
#pragma unroll
        for (unsigned j = 0; j < 16; ++j) { const unsigned c = xb_ld(&bar[XB_XCNT(j)]); sum += c; cnt += (c > 0u) ? 1u : 0u; mine = (j == x) ? c : mine; }
        if (sum == G) break;
        __builtin_amdgcn_s_sleep(1);
        if ((++sp & 255u) == 0u) { if (xb_ld(&bar[XB_TMO])) break; if (sp > XB_SPIN_CAP) { atomicAdd(&bar[XB_TMO], 1u); break; } }
    }
    nloc = mine > 0u ? mine : 1u; nx = cnt > 0u ? cnt : 1u;
}
__device__ __forceinline__ void xcd_barrier(const XcdBarrier& b) {
    asm volatile("s_waitcnt vmcnt(0)" ::: "memory");
    __syncthreads();
    if (threadIdx.x == 0) {
        unsigned* bar = b.bar;
        __builtin_amdgcn_s_waitcnt(0);
        unsigned nloc = b.st[0], nx = b.st[1];
        if (nloc == 0u) { xcd_barrier_complete(bar, b.x, nloc, nx); b.st[0] = nloc; b.st[1] = nx; }
        const unsigned old = xb_add(&bar[XB_XSUB(b.x)], 1u);
        const unsigned gen = old / nloc;
        if (old + 1u == (gen + 1u) * nloc) {
            __builtin_amdgcn_fence(__ATOMIC_RELEASE, "agent");
            asm volatile("s_waitcnt vmcnt(0)" ::: "memory");
            const unsigned og = xb_add(&bar[XB_TOP], 1u);
            const unsigned tg = og / nx;
            if (og + 1u == (tg + 1u) * nx) xb_add(&bar[XB_TOPGEN], 1u);
            else XB_SPIN(xb_ld(&bar[XB_TOPGEN]) == tg, bar);
            __builtin_amdgcn_fence(__ATOMIC_ACQUIRE, "agent");
            xb_add(&bar[XB_XGEN(b.x)], 1u);
            asm volatile("s_waitcnt vmcnt(0)" ::: "memory");
        } else {
            XB_SPIN(xb_ld(&bar[XB_XGEN(b.x)]) == gen, bar);
            __builtin_amdgcn_fence(__ATOMIC_ACQUIRE, "agent");
            asm volatile("s_waitcnt vmcnt(0)" ::: "memory");
        }
    }
    __syncthreads();
}

constexpr int BM = 256, BK = 64, HALF = 128, HTB = HALF * BK * 2, NXCD = 8, WGM = 8;
__device__ __forceinline__ int lds_byte(int r, int c) { const int st = (r >> 4) * 2 + (c >> 5), rr = r & 15, cc = c & 31, ob = rr * 64 + cc * 2; return st * 1024 + (ob ^ (((ob >> 9) & 1) << 5)); }
__device__ __forceinline__ void stage_rc(int b, int& R, int& C) { const int st = b / 1024, sb = b % 1024, swz = sb ^ (((sb >> 9) & 1) << 5); R = (st >> 1) * 16 + swz / 64; C = (st & 1) * 32 + (swz % 64) / 2; }
__device__ __forceinline__ int perm32(int rho) { const int n = rho >> 4, i = rho & 15; return 8 * (i >> 2) + 4 * n + (i & 3); }

struct Unit { int pm, pn, g; };
struct Gemm { const bf16_t* A; const bf16_t* B; int lda, ldb, K; size_t batchA, batchB; int hzero; };
struct Sched {
    int nM, nN, per, tot, G, c;
    __device__ void init(int M, int N, int nG, int G_, int c_) { nM = M / BM; nN = N / BM; per = nM * nN; tot = per * nG; G = G_; c = c_; }
    __device__ bool next(int i, Unit& u) const {
        const long L = (long)i * G + c; if (L >= tot) return false;
        int wgid = (int)L; { const int q = tot / NXCD, r = tot % NXCD, xcd = wgid % NXCD, off = wgid / NXCD; wgid = (xcd < r ? xcd * (q + 1) : r * (q + 1) + (xcd - r) * q) + off; }
        u.g = wgid / per; const int w = wgid % per;
        const int nig = WGM * nN, gid = w / nig, fm = gid * WGM, gsz = (nM - fm) < WGM ? (nM - fm) : WGM;
        u.pm = fm + ((w % nig) % gsz); u.pn = (w % nig) / gsz; return true;
    }
};

template <class Epi>
__device__ __forceinline__ void gemm_phase(LAS unsigned char* lds, const Gemm g, const Sched& S, const Epi& E) {
    int tid = threadIdx.x; asm volatile("" : "+v"(tid));
    const int wid = __builtin_amdgcn_readfirstlane(tid >> 6), lane = tid & 63, wr = wid >> 2, wc = wid & 3, fr = lane & 15, fq = lane >> 4;
    const int nt = g.K / BK;
    unsigned voffA[2], voffB[2];
#pragma unroll
    for (int i = 0; i < 2; ++i) { int R, C; stage_rc(tid * 16 + i * 8192, R, C); const int Rb = (R & ~31) + perm32(R & 31);
        voffA[i] = (unsigned)(R * g.lda + C) * 2u; voffB[i] = (unsigned)(Rb * g.ldb + C) * 2u; }
    const size_t kstep = (size_t)(BK * 2);
    const size_t hstepA = (size_t)HALF * g.lda * 2, hstepB = g.hzero ? (size_t)0 : (size_t)HALF * g.ldb * 2;
    const size_t tstepA = 2 * (size_t)HALF * g.lda * 2, tstepB = 2 * (size_t)HALF * g.ldb * 2;
    const unsigned ldsw = (unsigned)wid * 1024u;
    const int aoff = lds_byte(wr * 64 + fr, fq * 8), boff = lds_byte(wc * 32 + fr, fq * 8);
#define G_SA(b, h) (((b) * 2 + (h)) * HTB)
#define G_SB(b, h) ((4 + (b) * 2 + (h)) * HTB)
#define G_STAGE(bufoff, gbase, voff) do { _Pragma("unroll") for (int _i = 0; _i < 2; ++_i) \
        __builtin_amdgcn_global_load_lds((const unsigned*)((const char*)(gbase) + (voff)[_i]), (LAS unsigned*)(lds + (bufoff) + ldsw + _i * 8192), 16, 0, 0); } while (0)
#define G_LDA(dst, b, h) do { _Pragma("unroll") for (int m = 0; m < 4; ++m) _Pragma("unroll") for (int k = 0; k < 2; ++k) dst[m][k] = *(const LAS bf16x8*)(lds + G_SA(b, h) + aoff + m * 2048 + k * 1024); } while (0)
#define G_LDB(dst, b, h) do { _Pragma("unroll") for (int n = 0; n < 2; ++n) _Pragma("unroll") for (int k = 0; k < 2; ++k) dst[n][k] = *(const LAS bf16x8*)(lds + G_SB(b, h) + boff + n * 2048 + k * 1024); } while (0)
#define G_MMA(ai, bj, At, Bt) do { __builtin_amdgcn_s_setprio(1); _Pragma("unroll") for (int m = 0; m < 4; ++m) _Pragma("unroll") for (int n = 0; n < 2; ++n) _Pragma("unroll") for (int k = 0; k < 2; ++k) \
        acc[ai][bj][m][n] = __builtin_amdgcn_mfma_f32_16x16x32_bf16(Bt[n][k], At[m][k], acc[ai][bj][m][n], 0, 0, 0); __builtin_amdgcn_s_setprio(0); } while (0)
#define G_WAIT_V(n) asm volatile("s_waitcnt vmcnt(" #n ")" ::: "memory")
#define G_WAIT_L(n) asm volatile("s_waitcnt lgkmcnt(" #n ")" ::: "memory")
#define G_BAR __builtin_amdgcn_s_barrier()
#define G_SCHED __builtin_amdgcn_sched_barrier(0)
    Unit cur, nxt; int ui = 0;
    if (!S.next(0, cur)) return;
    f32x4 acc[2][2][4][2];
#pragma unroll
    for (int a = 0; a < 2; ++a)
#pragma unroll
        for (int b = 0; b < 2; ++b)
#pragma unroll
            for (int m = 0; m < 4; ++m)
#pragma unroll
                for (int n = 0; n < 2; ++n) acc[a][b][m][n] = (f32x4){0.f, 0.f, 0.f, 0.f};
    bf16x8 At[4][2], B0[2][2], B1[2][2];
    const char* cA = (const char*)g.A + (size_t)cur.g * g.batchA + (size_t)cur.pm * tstepA; const char* cB = (const char*)g.B + (size_t)cur.g * g.batchB + (size_t)cur.pn * tstepB;
    G_STAGE(G_SB(0, 0), cB, voffB); G_STAGE(G_SA(0, 0), cA, voffA); G_STAGE(G_SB(0, 1), cB + hstepB, voffB); G_STAGE(G_SA(0, 1), cA + hstepA, voffA);
    if (wr == 1) G_BAR;
    G_WAIT_V(4); G_BAR;
    G_STAGE(G_SB(1, 0), cB + kstep, voffB); G_STAGE(G_SA(1, 0), cA + kstep, voffA); G_STAGE(G_SB(1, 1), cB + hstepB + kstep, voffB);
    G_WAIT_V(6); G_BAR;
    for (;;) {
        const bool has_next = S.next(ui + 1, nxt);
        const char* nA = has_next ? (const char*)g.A + (size_t)nxt.g * g.batchA + (size_t)nxt.pm * tstepA : cA;
        const char* nB = has_next ? (const char*)g.B + (size_t)nxt.g * g.batchB + (size_t)nxt.pn * tstepB : cB;
        for (int t = 0; t < nt; t += 2) {
            const bool last = (t == nt - 2);
            const char* a1 = cA + (size_t)(t + 1) * kstep;
            const char* a2 = last ? nA : cA + (size_t)(t + 2) * kstep; const char* b2 = last ? nB : cB + (size_t)(t + 2) * kstep;
            const char* a3 = a2 + kstep; const char* b3 = b2 + kstep;
            G_LDB(B0, 0, 0); G_SCHED; G_LDA(At, 0, 0); G_STAGE(G_SA(1, 1), a1 + hstepA, voffA);
            G_WAIT_L(8); G_BAR; G_WAIT_L(0); G_MMA(0, 0, At, B0); G_BAR; G_SCHED;
            G_LDB(B1, 0, 1); G_STAGE(G_SB(0, 0), b2, voffB);
            G_BAR; G_WAIT_L(0); G_MMA(0, 1, At, B1); G_BAR;
            G_LDA(At, 0, 1); G_STAGE(G_SA(0, 0), a2, voffA);
            G_BAR; G_WAIT_L(0); G_MMA(1, 0, At, B0); G_BAR; G_SCHED;
            G_STAGE(G_SB(0, 1), b2 + hstepB, voffB);
            G_WAIT_V(6); G_BAR; G_MMA(1, 1, At, B1); G_BAR;
            G_LDB(B0, 1, 0); G_SCHED; G_LDA(At, 1, 0); G_STAGE(G_SA(0, 1), a2 + hstepA, voffA);
            G_WAIT_L(8); G_BAR; G_WAIT_L(0); G_MMA(0, 0, At, B0); G_BAR; G_SCHED;
            G_LDB(B1, 1, 1); G_STAGE(G_SB(1, 0), b3, voffB);
            G_BAR; G_WAIT_L(0); G_MMA(0, 1, At, B1); G_BAR;
            G_LDA(At, 1, 1); G_STAGE(G_SA(1, 0), a3, voffA);
            G_BAR; G_WAIT_L(0); G_MMA(1, 0, At, B0); G_BAR; G_SCHED;
            G_STAGE(G_SB(1, 1), b3 + hstepB, voffB);
            G_WAIT_V(6); G_BAR; G_MMA(1, 1, At, B1); G_BAR;
        }
        { int fr2 = fr, fq2 = fq; asm volatile("" : "+v"(fr2), "+v"(fq2));
          E(acc, cur, wr, wc, fr2, fq2); }
        if (!has_next) break;
#pragma unroll
        for (int a = 0; a < 2; ++a)
#pragma unroll
            for (int b = 0; b < 2; ++b)
#pragma unroll
                for (int m = 0; m < 4; ++m)
#pragma unroll
                    for (int n = 0; n < 2; ++n) acc[a][b][m][n] = (f32x4){0.f, 0.f, 0.f, 0.f};
        cur = nxt; cA = nA; cB = nB; ++ui;
    }
    G_WAIT_V(0);
    if (wr == 0) G_BAR;
    G_BAR;
#undef G_SA
#undef G_SB
#undef G_STAGE
#undef G_LDA
#undef G_LDB
#undef G_MMA
#undef G_WAIT_V
#undef G_WAIT_L
#undef G_BAR
#undef G_SCHED
}

typedef f32x4 Acc[2][2][4][2];
__device__ __forceinline__ void row_stats(const float* st, int row, bool ln, float& mu, float& rstd) {
    if (ln) { const f32x4 a = *(const f32x4*)(st + 8 * (size_t)row), b = *(const f32x4*)(st + 8 * (size_t)row + 4); const float sx = (a[0] + a[2]) + (b[0] + b[2]), sy = (a[1] + a[3]) + (b[1] + b[3]);
        mu = sx * (1.0f / 1024.0f); const float var = sy * (1.0f / 1024.0f) - mu * mu; rstd = __builtin_amdgcn_rsqf(var + LN_EPS); }
    else { mu = 0.f; rstd = 1.f; }
}
#define ROW_STATS8(st, lnflag, MU, RS) float MU[8], RS[8]; { f32x4 sa_[8], sb_[8]; \
    _Pragma("unroll") for (int r_ = 0; r_ < 8; ++r_) { const int row_ = ROW_OF(u, r_ >> 2, r_ & 3); if (lnflag) { sa_[r_] = *(const f32x4*)((st) + 8 * (size_t)row_); sb_[r_] = *(const f32x4*)((st) + 8 * (size_t)row_ + 4); } } \
    _Pragma("unroll") for (int r_ = 0; r_ < 8; ++r_) { if (lnflag) { const float sx_ = (sa_[r_][0] + sa_[r_][2]) + (sb_[r_][0] + sb_[r_][2]), sy_ = (sa_[r_][1] + sa_[r_][3]) + (sb_[r_][1] + sb_[r_][3]); \
        MU[r_] = sx_ * (1.0f / 1024.0f); RS[r_] = __builtin_amdgcn_rsqf(sy_ * (1.0f / 1024.0f) - MU[r_] * MU[r_] + LN_EPS); } else { MU[r_] = 0.f; RS[r_] = 1.f; } \
        asm volatile("" : "+v"(MU[r_]), "+v"(RS[r_])); } asm volatile("" ::: "memory"); __builtin_amdgcn_sched_barrier(0); }
#define EPI_ROWS(ai, m) for (int ai = 0; ai < 2; ++ai) for (int m = 0; m < 4; ++m)
#define ROW_OF(u, ai, m) ((u).pm * BM + (ai) * HALF + wr * 64 + (m) * 16 + fr)
#define COL_OF(u, bj) ((u).pn * BM + (bj) * HALF + wc * 32 + 8 * fq)

#define ROWLOOP _Pragma("unroll") for (int ai = 0; ai < 2; ++ai) _Pragma("unroll") for (int m = 0; m < 4; ++m)
#define BJLOOP _Pragma("unroll") for (int bj = 0; bj < 2; ++bj)
#define PIN(ai, m) asm volatile("" : "+v"(acc[ai][0][m][0]), "+v"(acc[ai][0][m][1]), "+v"(acc[ai][1][m][0]), "+v"(acc[ai][1][m][1]))
#define FENCE1 do { asm volatile("" ::: "memory"); __builtin_amdgcn_sched_barrier(0); } while (0)
#define FENCE2 do { if (m & 1) { asm volatile("" ::: "memory"); __builtin_amdgcn_sched_barrier(0); } } while (0)

struct EpiIn {
    const float* st; const float* c1; const float* c2; bf16_t* Q; bf16_t* Aaug; int ln;
    __device__ __forceinline__ void operator()(Acc& acc, const Unit& u, int wr, int wc, int fr, int fq) const {
        {
            ROW_STATS8(st, ln, mu8, rs8);
            f32x4 k1a[2], k1b[2], k2a[2], k2b[2]; const f32x4 z = {0.f, 0.f, 0.f, 0.f};
            BJLOOP { const int c0 = COL_OF(u, bj); k1a[bj] = ln ? *(const f32x4*)(c1 + c0) : z; k1b[bj] = ln ? *(const f32x4*)(c1 + c0 + 4) : z; k2a[bj] = ln ? *(const f32x4*)(c2 + c0) : z; k2b[bj] = ln ? *(const f32x4*)(c2 + c0 + 4) : z; }
            ROWLOOP { const float mu = mu8[ai * 4 + m], rstd = rs8[ai * 4 + m];
                BJLOOP { acc[ai][bj][m][0] = (acc[ai][bj][m][0] - mu * k1a[bj]) * rstd + k2a[bj]; acc[ai][bj][m][1] = (acc[ai][bj][m][1] - mu * k1b[bj]) * rstd + k2b[bj]; }
                PIN(ai, m); FENCE2; }
        }
        asm volatile("" : "+v"(fr), "+v"(fq) :: "memory");
        BJLOOP { const int c0 = COL_OF(u, bj);
            ROWLOOP { const int row = ROW_OF(u, ai, m); const u32x4 w = pack8(acc[ai][bj][m][0], acc[ai][bj][m][1]);
                if (c0 < 512) *(u32x4*)(Q + (size_t)row * 512 + c0) = w;
                else { const int cc = c0 - 512, gg = cc >> 4, c = cc & 15; *(u32x4*)(Aaug + ((size_t)gg * 1024 + (row >> 6)) * 1152 + (row & 63) * 16 + c) = w; } FENCE2; } }
    }
};
struct EpiLoc {
    float* Loc;
    __device__ __forceinline__ void operator()(Acc& acc, const Unit& u, int wr, int wc, int fr, int fq) const {
        const int c0 = wc * 32 + 8 * fq;
        ROWLOOP { const int row = ROW_OF(u, ai, m); float* dst = Loc + ((size_t)u.g * 1024 + row) * 128 + c0;
            *(f32x4*)dst = acc[ai][0][m][0]; *(f32x4*)(dst + 4) = acc[ai][0][m][1]; FENCE2; }
    }
};
struct EpiSsm {
    const bf16_t* Aaug; const float* dvec; bf16_t* YG;
    __device__ __forceinline__ void operator()(Acc& acc, const Unit& u, int wr, int wc, int fr, int fq) const {
        {
            f32x4 da[2], db[2]; u32x4 uw[2][2];
            BJLOOP { const int c = COL_OF(u, bj) & 15; da[bj] = *(const f32x4*)(dvec + u.g * 16 + c); db[bj] = *(const f32x4*)(dvec + u.g * 16 + c + 4); }
#define SSM_LOAD(r, s) do { const int row_ = ROW_OF(u, (r) >> 2, (r) & 3); BJLOOP uw[s][bj] = *(const u32x4*)(Aaug + ((size_t)u.g * 1024 + row_) * 1152 + COL_OF(u, bj)); } while (0)
            SSM_LOAD(0, 0);
#pragma unroll
            for (int r = 0; r < 8; ++r) {
                if (r + 1 < 8) SSM_LOAD(r + 1, (r + 1) & 1);
                __builtin_amdgcn_sched_barrier(0);
                const int ai = r >> 2, m = r & 3, s = r & 1;
                BJLOOP { f32x4 ua, ub; unpack8(uw[s][bj], ua, ub);
                    f32x4 ya = acc[ai][bj][m][0] + da[bj] * ua, yb = acc[ai][bj][m][1] + db[bj] * ub;
#pragma unroll
                    for (int j = 0; j < 4; ++j) { ya[j] = gelu_tanh(ya[j]); yb[j] = gelu_tanh(yb[j]); }
                    acc[ai][bj][m][0] = ya; acc[ai][bj][m][1] = yb; }
                PIN(ai, m); asm volatile("" ::: "memory"); __builtin_amdgcn_sched_barrier(0);
            }
#undef SSM_LOAD
        }
        asm volatile("" : "+v"(fr), "+v"(fq) :: "memory");
        BJLOOP { const int c0 = COL_OF(u, bj), tl = c0 >> 4, c = c0 & 15;
            ROWLOOP { const int row = ROW_OF(u, ai, m); *(u32x4*)(YG + ((size_t)row * 64 + tl) * 512 + u.g * 16 + c) = pack8(acc[ai][bj][m][0], acc[ai][bj][m][1]); FENCE2; } }
    }
};
struct EpiGlu {
    const bf16_t* YG; const float* bias; bf16_t* MIX;
    __device__ __forceinline__ void operator()(Acc& acc, const Unit& u, int wr, int wc, int fr, int fq) const {
        {
            f32x4 ba[2], bb[2]; u32x4 yw[2][2];
            BJLOOP { const int c0 = COL_OF(u, bj); ba[bj] = *(const f32x4*)(bias + c0); bb[bj] = *(const f32x4*)(bias + c0 + 4); }
#define GLU_LOAD(r, s) do { const int row_ = ROW_OF(u, (r) >> 2, (r) & 3); BJLOOP yw[s][bj] = *(const u32x4*)(YG + (size_t)row_ * 512 + COL_OF(u, bj)); } while (0)
            GLU_LOAD(0, 0);
#pragma unroll
            for (int r = 0; r < 8; ++r) {
                if (r + 1 < 8) GLU_LOAD(r + 1, (r + 1) & 1);
                __builtin_amdgcn_sched_barrier(0);
                const int ai = r >> 2, m = r & 3, s = r & 1;
                BJLOOP { f32x4 ya, yb; unpack8(yw[s][bj], ya, yb);
                    f32x4 ga = acc[ai][bj][m][0] + ba[bj], gb = acc[ai][bj][m][1] + bb[bj];
#pragma unroll
                    for (int j = 0; j < 4; ++j) { ga[j] = ya[j] * sigmoidf_(ga[j]); gb[j] = yb[j] * sigmoidf_(gb[j]); }
                    acc[ai][bj][m][0] = ga; acc[ai][bj][m][1] = gb; }
                PIN(ai, m); asm volatile("" ::: "memory"); __builtin_amdgcn_sched_barrier(0);
            }
#undef GLU_LOAD
        }
        asm volatile("" : "+v"(fr), "+v"(fq) :: "memory");
        BJLOOP { const int c0 = COL_OF(u, bj);
            ROWLOOP { const int row = ROW_OF(u, ai, m); *(u32x4*)(MIX + (size_t)row * 1024 + 512 + c0) = pack8(acc[ai][bj][m][0], acc[ai][bj][m][1]); FENCE2; } }
    }
};
__device__ __forceinline__ void stats_publish(LAS unsigned char* red, float* st, const Acc& acc, const Unit& u, int wr, int wc, int fr, int fq) {
    LAS f32x2* R = (LAS f32x2*)red + wr * 512;
#pragma unroll
    for (int ai = 0; ai < 2; ++ai)
#pragma unroll
        for (int m = 0; m < 4; ++m) { float s = 0.f, ss = 0.f;
#pragma unroll
            for (int bj = 0; bj < 2; ++bj) { const f32x4 va = acc[ai][bj][m][0], vb = acc[ai][bj][m][1];
                s += (va[0] + va[1]) + (va[2] + va[3]) + (vb[0] + vb[1]) + (vb[2] + vb[3]);
                ss += (va[0] * va[0] + va[1] * va[1]) + (va[2] * va[2] + va[3] * va[3]) + (vb[0] * vb[0] + vb[1] * vb[1]) + (vb[2] * vb[2] + vb[3] * vb[3]); }
            s += __shfl_xor(s, 16); s += __shfl_xor(s, 32); ss += __shfl_xor(ss, 16); ss += __shfl_xor(ss, 32);
            if (fq == 0) R[((ai * 4 + m) * 16 + fr) * 4 + wc] = (f32x2){s, ss}; }
    asm volatile("s_waitcnt lgkmcnt(0)" ::: "memory"); __builtin_amdgcn_s_barrier(); asm volatile("" ::: "memory");
    const int lane = fq * 16 + fr;
    if (lane < 32) { const int rl = wc * 32 + lane; const f32x2 a = R[rl * 4], b = R[rl * 4 + 1], c = R[rl * 4 + 2], d = R[rl * 4 + 3];
        const int ai = rl >> 6, m = (rl >> 4) & 3, f = rl & 15; const int row = u.pm * BM + ai * HALF + wr * 64 + m * 16 + f;
        *(f32x2*)(st + ((size_t)row * 4 + u.pn) * 2) = (f32x2){(a.x + b.x) + (c.x + d.x), (a.y + b.y) + (c.y + d.y)}; }
}
template <bool STATS, bool SRC32>
struct EpiRes {
    const float* src32; const bf16_t* srcX; const float* st_in; const float* gam; const float* bet; int ln; bf16_t* X; signed char* LO; float* st_out; LAS unsigned char* red;
    __device__ __forceinline__ void operator()(Acc& acc, const Unit& u, int wr, int wc, int fr, int fq) const {
        ROW_STATS8(st_in, (!SRC32), mu8, rs8);
        f32x4 ga[2], gb[2], ba[2], bb[2];
        BJLOOP { const int c0 = COL_OF(u, bj);
            if (ln) { ga[bj] = *(const f32x4*)(gam + c0); gb[bj] = *(const f32x4*)(gam + c0 + 4); ba[bj] = *(const f32x4*)(bet + c0); bb[bj] = *(const f32x4*)(bet + c0 + 4); } }
        if (SRC32) {
        ROWLOOP { const int row = ROW_OF(u, ai, m); float mu, rstd; row_stats(st_in, row, ln, mu, rstd);
            BJLOOP { const size_t off = (size_t)row * 1024 + COL_OF(u, bj);
                f32x4 ha = *(const f32x4*)(src32 + off), hb = *(const f32x4*)(src32 + off + 4);
                if (ln) { ha = (ha - mu) * rstd * ga[bj] + ba[bj]; hb = (hb - mu) * rstd * gb[bj] + bb[bj]; }
                acc[ai][bj][m][0] += ALPHA * ha; acc[ai][bj][m][1] += ALPHA * hb; }
            PIN(ai, m); FENCE2; }
        } else {
            u32x4 hi[2][2], lo4[2];
#define RES_LOAD(r, s) do { const int row_ = ROW_OF(u, (r) >> 2, (r) & 3); \
                lo4[s] = *(const u32x4*)(LO + lo_off(row_, u.pn, wc, fq)); BJLOOP { const size_t off_ = (size_t)row_ * 1024 + COL_OF(u, bj); hi[s][bj] = *(const u32x4*)(srcX + off_); } } while (0)
            RES_LOAD(0, 0);
#pragma unroll
            for (int r = 0; r < 8; ++r) {
                if (r + 1 < 8) RES_LOAD(r + 1, (r + 1) & 1);
                __builtin_amdgcn_sched_barrier(0);
                const int ai = r >> 2, m = r & 3, s = r & 1;
                const float mu = mu8[r], rstd = rs8[r];
                BJLOOP { f32x4 ha, hb; hl_decode(hi[s][bj], bj ? (u32x2){lo4[s].z, lo4[s].w} : (u32x2){lo4[s].x, lo4[s].y}, ha, hb);
                    ha = (ha - mu) * rstd * ga[bj] + ba[bj]; hb = (hb - mu) * rstd * gb[bj] + bb[bj];
                    acc[ai][bj][m][0] += ALPHA * ha; acc[ai][bj][m][1] += ALPHA * hb; }
                PIN(ai, m); asm volatile("" ::: "memory"); __builtin_amdgcn_sched_barrier(0);
            }
#undef RES_LOAD
        }
        asm volatile("" : "+v"(fr), "+v"(fq) :: "memory");
        ROWLOOP { const int row = ROW_OF(u, ai, m);
            { u32x4 w0, w1; u32x2 l0, l1; hl_pack(acc[ai][0][m][0], acc[ai][0][m][1], w0, l0); hl_pack(acc[ai][1][m][0], acc[ai][1][m][1], w1, l1);
              *(u32x4*)(X + (size_t)row * 1024 + COL_OF(u, 0)) = w0; *(u32x4*)(X + (size_t)row * 1024 + COL_OF(u, 1)) = w1; *(u32x4*)(LO + lo_off(row, u.pn, wc, fq)) = (u32x4){l0.x, l0.y, l1.x, l1.y}; }
            FENCE1; }
        if (STATS) stats_publish(red, st_out, acc, u, wr, wc, fr, fq);
    }
};
struct EpiFfn {
    const float* st; const float* c1; const float* c2; bf16_t* HID;
    __device__ __forceinline__ void operator()(Acc& acc, const Unit& u, int wr, int wc, int fr, int fq) const {
        const int r0 = u.pn * 256 + wc * 32 + 8 * fq, hc = u.pn * 128 + wc * 32 + 8 * fq;
        ROW_STATS8(st, true, mu8, rs8);
        const f32x4 g1a = *(const f32x4*)(c1 + r0), g1b = *(const f32x4*)(c1 + r0 + 4), g2a = *(const f32x4*)(c2 + r0), g2b = *(const f32x4*)(c2 + r0 + 4);
        const f32x4 u1a = *(const f32x4*)(c1 + r0 + 128), u1b = *(const f32x4*)(c1 + r0 + 132), u2a = *(const f32x4*)(c2 + r0 + 128), u2b = *(const f32x4*)(c2 + r0 + 132);
        ROWLOOP { const float mu = mu8[ai * 4 + m], rstd = rs8[ai * 4 + m];
            f32x4 ga = (acc[ai][0][m][0] - mu * g1a) * rstd + g2a, gb = (acc[ai][0][m][1] - mu * g1b) * rstd + g2b;
            const f32x4 ua = (acc[ai][1][m][0] - mu * u1a) * rstd + u2a, ub = (acc[ai][1][m][1] - mu * u1b) * rstd + u2b;
#pragma unroll
            for (int j = 0; j < 4; ++j) { ga[j] = ga[j] * sigmoidf_(ga[j]) * ua[j]; gb[j] = gb[j] * sigmoidf_(gb[j]) * ub[j]; }
            acc[ai][0][m][0] = ga; acc[ai][0][m][1] = gb; PIN(ai, m); FENCE2; }
        asm volatile("" : "+v"(fr), "+v"(fq) :: "memory");
        ROWLOOP { const int row = ROW_OF(u, ai, m); *(u32x4*)(HID + (size_t)row * H_ + hc) = pack8(acc[ai][0][m][0], acc[ai][0][m][1]); FENCE2; }
    }
};
struct EpiPle {
    bf16_t* E;
    __device__ __forceinline__ void operator()(Acc& acc, const Unit& u, int wr, int wc, int fr, int fq) const {
        ROWLOOP { const int row = ROW_OF(u, ai, m);
            BJLOOP *(u32x4*)(E + (size_t)row * 1024 + COL_OF(u, bj)) = pack8(acc[ai][bj][m][0], acc[ai][bj][m][1]);
            FENCE2; }
    }
};
struct EpiGate {
    const bf16_t* E; const bf16_t* Xr; bf16_t* X; signed char* LO; float* st_out; LAS unsigned char* red;
    __device__ __forceinline__ void operator()(Acc& acc, const Unit& u, int wr, int wc, int fr, int fq) const {
        {
            u32x4 hi[2][2], ee[2][2], lo4[2];
#define GATE_LOAD(r, s) do { const int row_ = ROW_OF(u, (r) >> 2, (r) & 3); \
                lo4[s] = *(const u32x4*)(LO + lo_off(row_, u.pn, wc, fq)); BJLOOP { const size_t off_ = (size_t)row_ * 1024 + COL_OF(u, bj); hi[s][bj] = *(const u32x4*)(Xr + off_); ee[s][bj] = *(const u32x4*)(E + off_); } } while (0)
            GATE_LOAD(0, 0);
#pragma unroll
            for (int r = 0; r < 8; ++r) {
                if (r + 1 < 8) GATE_LOAD(r + 1, (r + 1) & 1);
                __builtin_amdgcn_sched_barrier(0);
                const int ai = r >> 2, m = r & 3, s = r & 1;
                BJLOOP { f32x4 ra, rb; hl_decode(hi[s][bj], bj ? (u32x2){lo4[s].z, lo4[s].w} : (u32x2){lo4[s].x, lo4[s].y}, ra, rb); f32x4 ea, eb; unpack8(ee[s][bj], ea, eb);
                    f32x4 va, vb;
#pragma unroll
                    for (int j = 0; j < 4; ++j) { va[j] = ra[j] + ea[j] * sigmoidf_(acc[ai][bj][m][0][j]); vb[j] = rb[j] + eb[j] * sigmoidf_(acc[ai][bj][m][1][j]); }
                    acc[ai][bj][m][0] = va; acc[ai][bj][m][1] = vb; }
                PIN(ai, m); asm volatile("" ::: "memory"); __builtin_amdgcn_sched_barrier(0);
            }
#undef GATE_LOAD
        }
        asm volatile("" : "+v"(fr), "+v"(fq) :: "memory");
        ROWLOOP { const int row = ROW_OF(u, ai, m);
            { u32x4 w0, w1; u32x2 l0, l1; hl_pack(acc[ai][0][m][0], acc[ai][0][m][1], w0, l0); hl_pack(acc[ai][1][m][0], acc[ai][1][m][1], w1, l1);
              *(u32x4*)(X + (size_t)row * 1024 + COL_OF(u, 0)) = w0; *(u32x4*)(X + (size_t)row * 1024 + COL_OF(u, 1)) = w1; *(u32x4*)(LO + lo_off(row, u.pn, wc, fq)) = (u32x4){l0.x, l0.y, l1.x, l1.y}; }
            FENCE1; }
        stats_publish(red, st_out, acc, u, wr, wc, fr, fq);
    }
};

__device__ void transpose_job(float* tile  , const float* src, int lds_, int K, int N, const float* scale, bf16_t* dst, int mode, int off, int& base,
                              const float* bet = nullptr, float* c1 = nullptr, float* c2 = nullptr, int coff = 0) {
    const int tid = threadIdx.x, G = gridDim.x, nkt = K / 64, nnt = N / 64, ntile = nkt * nnt;
    int first = ((int)blockIdx.x - base) % G; if (first < 0) first += G;
    for (int t = first; t < ntile; t += G) {
        const int kt = t / nnt, ntl = t % nnt;
        __syncthreads();
#pragma unroll
        for (int pss = 0; pss < 2; ++pss) { const int kk = pss * 32 + (tid >> 4), n4 = (tid & 15) * 4;
            const f32x4 v = *(const f32x4*)(src + (size_t)(kt * 64 + kk) * lds_ + ntl * 64 + n4);
            tile[(n4 + 0) * 65 + kk] = v[0]; tile[(n4 + 1) * 65 + kk] = v[1]; tile[(n4 + 2) * 65 + kk] = v[2]; tile[(n4 + 3) * 65 + kk] = v[3]; }
        __syncthreads();
        { const int n = tid >> 3, k8 = (tid & 7) * 8; const float* r = tile + n * 65 + k8;
            float sc[8];
#pragma unroll
            for (int j = 0; j < 8; ++j) sc[j] = scale ? scale[kt * 64 + k8 + j] : 1.0f;
            u32x4 w; w.x = cvt_pk(r[0] * sc[0], r[1] * sc[1]); w.y = cvt_pk(r[2] * sc[2], r[3] * sc[3]); w.z = cvt_pk(r[4] * sc[4], r[5] * sc[5]); w.w = cvt_pk(r[6] * sc[6], r[7] * sc[7]);
            const int ng = ntl * 64 + n; const int drow = mode ? ((ng >> 7) * 256 + (ng & 127) + off) : ng;
            *(u32x4*)(dst + (size_t)drow * K + kt * 64 + k8) = w;
            if (c1) {
                float s1 = (bflo(w.x) + bfhi(w.x)) + (bflo(w.y) + bfhi(w.y)) + (bflo(w.z) + bfhi(w.z)) + (bflo(w.w) + bfhi(w.w)), s2 = 0.f;
#pragma unroll
                for (int j = 0; j < 8; ++j) s2 += r[j] * bet[kt * 64 + k8 + j];
                s1 += __shfl_xor(s1, 1); s1 += __shfl_xor(s1, 2); s1 += __shfl_xor(s1, 4); s2 += __shfl_xor(s2, 1); s2 += __shfl_xor(s2, 2); s2 += __shfl_xor(s2, 4);
                if ((tid & 7) == 0) { atomicAdd(c1 + coff + drow, s1); atomicAdd(c2 + coff + drow, s2); } }
        }
    }
    base = (base + ntile) % G;
}

template <int W>
__device__ __forceinline__ void fir_item(const bf16_t* __restrict__ qb, bf16_t* __restrict__ mb, int t0, const f32x4 ba, const f32x4 bb, const f32x4 sa, const f32x4 sb) {
    constexpr int TS = 8, NR = W - 1 + TS;
    u32x4 raw[NR];
#pragma unroll
    for (int r = 0; r < NR; ++r) { const int t = t0 - (W - 1) + r; raw[r] = (t >= 0) ? *(const u32x4*)(qb + (size_t)t * 512) : (u32x4){0u, 0u, 0u, 0u}; }
    f32x4 sma = {0.f, 0.f, 0.f, 0.f}, smb = sma;
#pragma unroll
    for (int r = 0; r < W - 1; ++r) { f32x4 a, c; unpack8(raw[r], a, c); sma += a; smb += c; }
#pragma unroll
    for (int j = 0; j < TS; ++j) { const int t = t0 + j; f32x4 a, c; unpack8(raw[W - 1 + j], a, c); sma += a; smb += c;
        const float inv = 1.0f / (float)((t + 1) < W ? (t + 1) : W);
        *(u32x4*)(mb + (size_t)t * 1024) = pack8((sma * inv - a + ba) * sa, (smb * inv - c + bb) * sb);
        f32x4 a2, c2; unpack8(raw[j], a2, c2); sma -= a2; smb -= c2; }
}
__device__ __forceinline__ int bx_() { int b = blockIdx.x; asm volatile("" : "+s"(b)); return b; }
__global__ void __launch_bounds__(512, 2) fwd_megakernel(Params p) {
    extern __shared__ __attribute__((aligned(16))) unsigned char lds_raw[];
    LAS unsigned char* lds = (LAS unsigned char*)lds_raw;
    cg::grid_group grid = cg::this_grid();
    const int G = gridDim.x;
    { volatile LAS unsigned* xst = (volatile LAS unsigned*)(lds + 136 * 1024); if (threadIdx.x == 0) { xst[0] = 0u; xst[1] = 0u; } __syncthreads(); (void)xcd_barrier_post((unsigned*)(p.ws + WS_BAR), xst); }
#define GRID_BAR() do { XcdBarrier xb_; xb_.bar = (unsigned*)(p.ws + WS_BAR); xb_.x = xb_xcc_id(); xb_.st = (volatile LAS unsigned*)(lds + 136 * 1024); xcd_barrier(xb_); } while (0)
#define FRESH_TID() int tid = threadIdx.x; asm volatile("" : "+v"(tid)); const size_t gtid = (size_t)blockIdx.x * 512 + tid, gsz = (size_t)G * 512; (void)gsz; (void)gtid;
    unsigned char* ws = p.ws;
    const float* x = p.in[0]; const float* pin = p.in[1];
    bf16_t* X1 = (bf16_t*)(ws + WS_X1); bf16_t* X2 = (bf16_t*)(ws + WS_X2); bf16_t* PB = (bf16_t*)p.out;
    signed char* LO = (signed char*)(ws + WS_PB);
    float* STATS = (float*)(ws + WS_STATS2); float* LBP = (float*)(ws + WS_LBP); float* BBAR = (float*)(ws + WS_BBAR); float* KMAT = (float*)(ws + WS_KMAT);
    bf16_t* PG = (bf16_t*)(ws + WS_PG); float* LOC = (float*)(ws + WS_LOC); bf16_t* BAUG = (bf16_t*)(ws + WS_BAUG);
    float* WCOMB = (float*)(ws + WS_WCOMB); float* CVEC = (float*)(ws + WS_CVEC);
    bf16_t* AAUG = (bf16_t*)(ws + WS_BIG + BIG_AAUG); bf16_t* Q = (bf16_t*)(ws + WS_BIG + BIG_Q); bf16_t* YG = (bf16_t*)(ws + WS_BIG + BIG_YG);
    bf16_t* MIX = (bf16_t*)(ws + WS_BIG + BIG_MIX); bf16_t* HID = (bf16_t*)(ws + WS_BIG); bf16_t* EB = (bf16_t*)(ws + WS_BIG + BIG_E);

    { FRESH_TID();
    for (size_t i = gtid; i < (size_t)NL_ * CVEC_PER_LAYER; i += gsz) CVEC[i] = 0.f;
    for (size_t i = gtid; i < (size_t)T_ * D_ / 8; i += gsz) { const f32x4 a = ((const f32x4*)x)[2 * i], b = ((const f32x4*)x)[2 * i + 1]; ((u32x4*)X1)[i] = pack8(a, b); }
    for (size_t i = gtid; i < (size_t)NL_ * T_ * PLE_ / 8; i += gsz) { const f32x4 a = ((const f32x4*)pin)[2 * i], b = ((const f32x4*)pin)[2 * i + 1]; ((u32x4*)PB)[i] = pack8(a, b); }
    for (size_t it = gtid; it < (size_t)NL_ * 32 * 64 * 66; it += gsz) {
        const int i = (int)(it / 66), k = (int)(it % 66), lg = i >> 6;
        const double ar = fmin((double)p.in[6][i], -1e-4), aim = (double)p.in[7][i], dt = exp((double)p.in[8][lg]);
        if (k <= 64) { const double mag = exp(ar * dt * k), ang = aim * dt * k; LBP[((size_t)i * 65 + k) * 2] = (float)(mag * cos(ang)); LBP[((size_t)i * 65 + k) * 2 + 1] = (float)(mag * sin(ang)); }
        else { const double mag = exp(ar * dt), ang = aim * dt; const double nr = mag * cos(ang) - 1.0, ni = mag * sin(ang), den = ar * ar + aim * aim;
            const double qr = (nr * ar + ni * aim) / den, qi = (ni * ar - nr * aim) / den;
            for (int c = 0; c < 16; ++c) { const double br = (double)p.in[9][(size_t)i * 16 + c], bi = (double)p.in[10][(size_t)i * 16 + c];
                BBAR[((size_t)i * 16 + c) * 2] = (float)(qr * br - qi * bi); BBAR[((size_t)i * 16 + c) * 2 + 1] = (float)(qr * bi + qi * br); } }
    }
    for (size_t i = gtid; i < (size_t)NL_ * 1024 * 512; i += gsz) {
        const int d = (int)(i & 127), gp = (int)((i >> 7) & 3), k = (int)((i >> 9) & 1023), l = (int)(i >> 19);
        const float* wi = p.in[2] + ((size_t)l * 1024 + k) * 1024 + gp * 128; const float* wp = p.in[3] + ((size_t)(l * 4 + gp) * 128) * 128 + d;
        float s = 0.f;
        for (int c = 0; c < 128; ++c) s += wi[c] * wp[(size_t)c * 128];
        WCOMB[i] = s;
    }
    }
    if (gridDim.x == 0x7fffffffu) grid.sync();
    GRID_BAR();

    { FRESH_TID();
    for (size_t i = gtid; i < (size_t)NL_ * 32 * 64 * 16; i += gsz) {
        const int c = (int)(i & 15), lag = (int)((i >> 4) & 63), lg = (int)(i >> 10);
        const float* cre = p.in[11] + ((size_t)lg * 16 + c) * 64; const float* cim = p.in[12] + ((size_t)lg * 16 + c) * 64;
        f32x4 s0 = {0.f, 0.f, 0.f, 0.f}, s1 = s0, s2 = s0, s3 = s0;
        for (int n = 0; n < 64; ++n) { const size_t sn = (size_t)lg * 64 + n; const f32x2 pw = *(const f32x2*)(LBP + (sn * 65 + lag) * 2);
            const float er = cre[n] * pw.x - cim[n] * pw.y, ei = cre[n] * pw.y + cim[n] * pw.x;
            const f32x4* bb = (const f32x4*)(BBAR + sn * 32);
#pragma unroll
            for (int q = 0; q < 8; ++q) { const f32x4 b = bb[q]; const float v0 = er * b[0] - ei * b[1], v1 = er * b[2] - ei * b[3];
                if (q < 2) { s0[(q & 1) * 2] += v0; s0[(q & 1) * 2 + 1] += v1; } else if (q < 4) { s1[(q & 1) * 2] += v0; s1[(q & 1) * 2 + 1] += v1; }
                else if (q < 6) { s2[(q & 1) * 2] += v0; s2[(q & 1) * 2 + 1] += v1; } else { s3[(q & 1) * 2] += v0; s3[(q & 1) * 2 + 1] += v1; } } }
        f32x4* dst = (f32x4*)(KMAT + i * 16); dst[0] = s0; dst[1] = s1; dst[2] = s2; dst[3] = s3;
    }
    for (size_t i = gtid; i < (size_t)NL_ * 32 * 128 * 128; i += gsz) {
        const int v = (int)(i & 127), nri = (int)((i >> 7) & 127), lg = (int)(i >> 14); const int sl = v >> 1, c0 = (v & 1) * 8, n = nri >> 1, ri = nri & 1;
        const size_t sn = (size_t)lg * 64 + n; const float pr = LBP[(sn * 65 + (63 - sl)) * 2], pi = LBP[(sn * 65 + (63 - sl)) * 2 + 1];
        float o[8];
#pragma unroll
        for (int j = 0; j < 8; ++j) { const float br = BBAR[(sn * 16 + c0 + j) * 2], bi = BBAR[(sn * 16 + c0 + j) * 2 + 1]; o[j] = ri ? (pr * bi + pi * br) : (pr * br - pi * bi); }
        u32x4 w; w.x = cvt_pk(o[0], o[1]); w.y = cvt_pk(o[2], o[3]); w.z = cvt_pk(o[4], o[5]); w.w = cvt_pk(o[6], o[7]);
        *(u32x4*)(PG + ((size_t)lg * 128 + nri) * 1024 + sl * 16 + c0) = w;
    }
    {
        float* tile = (float*)lds_raw; int base = 0;
        for (int l = 0; l < NL_; ++l) {
            const float* g2p = l ? p.in[24] + (size_t)(l - 1) * 1024 : nullptr; const float* g1 = p.in[17] + (size_t)l * 1024;
            bf16_t* WIN = (bf16_t*)(ws + WS_WIN) + (size_t)l * 1024 * 1024;
            const float* b2p = l ? p.in[25] + (size_t)(l - 1) * 1024 : nullptr; const float* b1 = p.in[18] + (size_t)l * 1024; float* cvl = CVEC + (size_t)l * CVEC_PER_LAYER;
            transpose_job(tile, WCOMB + (size_t)l * 1024 * 512, 512, 1024, 512, g2p, WIN, 0, 0, base, b2p, l ? cvl : nullptr, cvl + 1024, 0);
            transpose_job(tile, p.in[2] + (size_t)l * 1024 * 1024 + 512, 1024, 1024, 512, g2p, WIN + (size_t)512 * 1024, 0, 0, base, b2p, l ? cvl : nullptr, cvl + 1024, 512);
            transpose_job(tile, p.in[16] + (size_t)l * 1024 * 1024, 1024, 1024, 1024, nullptr, (bf16_t*)(ws + WS_WOUT) + (size_t)l * 1024 * 1024, 0, 0, base);
            transpose_job(tile, p.in[23] + (size_t)l * 1024 * 1024, 1024, 1024, 1024, nullptr, (bf16_t*)(ws + WS_GATE) + (size_t)l * 1024 * 1024, 0, 0, base);
            transpose_job(tile, p.in[14] + (size_t)l * 512 * 512, 512, 512, 512, nullptr, (bf16_t*)(ws + WS_GLU) + (size_t)l * 512 * 512, 0, 0, base);
            transpose_job(tile, p.in[22] + (size_t)l * 256 * 1024, 1024, 256, 1024, nullptr, (bf16_t*)(ws + WS_PLE) + (size_t)l * 1024 * 256, 0, 0, base);
            transpose_job(tile, p.in[19] + (size_t)l * 1024 * H_, H_, 1024, H_, g1, (bf16_t*)(ws + WS_W13) + (size_t)l * 5632 * 1024, 1, 0, base, b1, cvl + 2048, cvl + 2048 + 5632, 0);
            transpose_job(tile, p.in[20] + (size_t)l * 1024 * H_, H_, 1024, H_, g1, (bf16_t*)(ws + WS_W13) + (size_t)l * 5632 * 1024, 1, 128, base, b1, cvl + 2048, cvl + 2048 + 5632, 0);
            transpose_job(tile, p.in[21] + (size_t)l * H_ * 1024, 1024, H_, 1024, nullptr, (bf16_t*)(ws + WS_W2) + (size_t)l * 1024 * H_, 0, 0, base);
        }
        __syncthreads();
    }
    }
    GRID_BAR();

    for (int l = 0; l < NL_; ++l) {
        const float* cv = CVEC + (size_t)l * CVEC_PER_LAYER;
        float* st1 = STATS + (size_t)(2 * l) * T_ * 8; float* st2 = STATS + (size_t)(2 * l + 1) * T_ * 8;
        const float* st2p = l ? STATS + (size_t)(2 * l - 1) * T_ * 8 : STATS;
        { Gemm g{X1, (const bf16_t*)(ws + WS_WIN) + (size_t)l * 1024 * 1024, 1024, 1024, 1024, 0, 0, 0}; Sched S; S.init(T_, 1024, 1, G, bx_());
          EpiIn E{st2p, cv, cv + 1024, Q, AAUG, l > 0}; gemm_phase(lds, g, S, E); }
        GRID_BAR();
        { Gemm g{AAUG, PG + (size_t)l * 32 * 128 * 1024, 1152, 1024, 1024, (size_t)1024 * 1152 * 2, (size_t)128 * 1024 * 2, 1}; Sched S; S.init(1024, 256, 32, G, bx_());
          EpiLoc E{LOC}; gemm_phase(lds, g, S, E);
          Unit u;
          if (S.next(0, u)) {
              FRESH_TID();
              __threadfence(); __syncthreads();
              const int bl = tid >> 6, n = tid & 63; const size_t sn = ((size_t)l * 32 + u.g) * 64 + n;
              const float ar = LBP[(sn * 65 + 64) * 2], ai_ = LBP[(sn * 65 + 64) * 2 + 1];
              float sr = 0.f, si = 0.f;
              const size_t row0 = (size_t)u.g * 1024 + u.pm * 256 + bl * 32;
              for (int j0 = 0; j0 < 32; j0 += 8) {
                  f32x2 lc[8];
#pragma unroll
                  for (int j = 0; j < 8; ++j) lc[j] = *(const f32x2*)(LOC + (row0 + j0 + j) * 128 + 2 * n);
#pragma unroll
                  for (int j = 0; j < 8; ++j) { *(unsigned*)(AAUG + (row0 + j0 + j) * 1152 + 1024 + 2 * n) = cvt_pk(sr, si);
                      const float nr = ar * sr - ai_ * si + lc[j].x, ni = ar * si + ai_ * sr + lc[j].y; sr = nr; si = ni; }
              }
          }
        }
        {
            FRESH_TID();
            for (size_t it = gtid; it < (size_t)32 * 256 * 64; it += gsz) {
                const int c16 = (int)(it & 15), tch = (int)((it >> 4) & 255), grp = (int)((it >> 12) & 3), b = (int)(it >> 14); const int cvv = grp * 16 + c16, t0 = tch * 8;
                const bf16_t* qb = Q + (size_t)b * SEQ_ * 512 + cvv * 8; bf16_t* mb = MIX + (size_t)b * SEQ_ * 1024 + cvv * 8;
                const float* pb = p.in[4] + (size_t)l * 512 + cvv * 8; const float* ps = p.in[5] + (size_t)l * 512 + cvv * 8;
                const f32x4 ba = *(const f32x4*)pb, bb = *(const f32x4*)(pb + 4), sa = *(const f32x4*)ps, sb = *(const f32x4*)(ps + 4);
                if (grp == 0) fir_item<2>(qb, mb, t0, ba, bb, sa, sb); else if (grp == 1) fir_item<4>(qb, mb, t0, ba, bb, sa, sb);
                else if (grp == 2) fir_item<8>(qb, mb, t0, ba, bb, sa, sb); else fir_item<16>(qb, mb, t0, ba, bb, sa, sb);
            }
        }
        const int nsw = G, swi = (int)blockIdx.x;
        { FRESH_TID();
        const float* kmat_l = KMAT + (size_t)l * 32 * 64 * 256;
        for (size_t i0 = gtid; i0 < (size_t)32 * 1024 * 128; i0 += 4 * gsz) {
            f32x4 a[4], b[4]; bool nz[4];
#pragma unroll
            for (int j = 0; j < 4; ++j) { const size_t i = i0 + j * gsz; const int kv = (int)(i & 127), rowi = (int)((i >> 7) & 1023), gg = (int)(i >> 17); const int tl = rowi >> 4, c = rowi & 15, sl = kv >> 1, c0 = (kv & 1) * 8;
                nz[j] = (i < (size_t)32 * 1024 * 128) && (sl <= tl);
                if (nz[j]) { const float* km = kmat_l + ((((size_t)gg * 64 + (tl - sl)) * 16 + c) * 16 + c0); a[j] = *(const f32x4*)km; b[j] = *(const f32x4*)(km + 4); }
                else { a[j] = (f32x4){0.f, 0.f, 0.f, 0.f}; b[j] = a[j]; } }
#pragma unroll
            for (int j = 0; j < 4; ++j) { const size_t i = i0 + j * gsz; if (i < (size_t)32 * 1024 * 128) { const int kv = (int)(i & 127); const size_t grow = i >> 7;
                *(u32x4*)(BAUG + grow * 1152 + kv * 8) = pack8(a[j], b[j]); } }
        }
        for (size_t i = gtid; i < (size_t)32 * 1024 * 16; i += gsz) {
            const int kv = (int)(i & 15), rowi = (int)((i >> 4) & 1023), gg = (int)(i >> 14); const int tl = rowi >> 4, c = rowi & 15, n0 = kv * 4; const size_t lg = (size_t)l * 32 + gg;
            const f32x4 cr = *(const f32x4*)(p.in[11] + (lg * 16 + c) * 64 + n0), ci = *(const f32x4*)(p.in[12] + (lg * 16 + c) * 64 + n0);
            float o[8];
#pragma unroll
            for (int j = 0; j < 4; ++j) { const f32x2 pw = *(const f32x2*)(LBP + ((lg * 64 + n0 + j) * 65 + tl + 1) * 2); o[2 * j] = cr[j] * pw.x - ci[j] * pw.y; o[2 * j + 1] = -(cr[j] * pw.y + ci[j] * pw.x); }
            u32x4 w; w.x = cvt_pk(o[0], o[1]); w.y = cvt_pk(o[2], o[3]); w.z = cvt_pk(o[4], o[5]); w.w = cvt_pk(o[6], o[7]);
            *(u32x4*)(BAUG + ((size_t)gg * 1024 + rowi) * 1152 + 1024 + kv * 8) = w;
        }
        }
        GRID_BAR();
        { Gemm g{AAUG, BAUG, 1152, 1152, 1152, (size_t)1024 * 1152 * 2, (size_t)1024 * 1152 * 2, 0}; Sched S; S.init(1024, 1024, 32, G, bx_());
          EpiSsm E{AAUG, p.in[13] + (size_t)l * 512, YG}; gemm_phase(lds, g, S, E); }
        GRID_BAR();
        { Gemm g{YG, (const bf16_t*)(ws + WS_GLU) + (size_t)l * 512 * 512, 512, 512, 512, 0, 0, 0}; Sched S; S.init(T_, 512, 1, G, bx_());
          EpiGlu E{YG, p.in[15] + (size_t)l * 512, MIX}; gemm_phase(lds, g, S, E); }
        GRID_BAR();
        { Gemm g{MIX, (const bf16_t*)(ws + WS_WOUT) + (size_t)l * 1024 * 1024, 1024, 1024, 1024, 0, 0, 0}; Sched S; S.init(T_, 1024, 1, G, bx_());
          if (l == 0) { EpiRes<true, true> E{x, nullptr, st2p, x, x, 0, X1, LO, st1, lds + 128 * 1024}; gemm_phase(lds, g, S, E); }
          else { EpiRes<true, false> E{nullptr, X1, st2p, p.in[24] + (size_t)(l - 1) * 1024, p.in[25] + (size_t)(l - 1) * 1024, 1, X1, LO, st1, lds + 128 * 1024}; gemm_phase(lds, g, S, E); } }
        GRID_BAR();
        { Gemm g{X1, (const bf16_t*)(ws + WS_W13) + (size_t)l * 5632 * 1024, 1024, 1024, 1024, 0, 0, 0}; Sched S; S.init(T_, 5632, 1, G, bx_());
          EpiFfn E{st1, cv + 2048, cv + 2048 + 5632, HID}; gemm_phase(lds, g, S, E); }
        GRID_BAR();
        { Gemm g{HID, (const bf16_t*)(ws + WS_W2) + (size_t)l * 1024 * H_, H_, H_, H_, 0, 0, 0}; Sched S; S.init(T_, 1024, 1, G, bx_());
          EpiRes<false, false> E{nullptr, X1, st1, p.in[17] + (size_t)l * 1024, p.in[18] + (size_t)l * 1024, 1, X2, LO, nullptr, lds + 128 * 1024}; gemm_phase(lds, g, S, E); }
        GRID_BAR();
        { Gemm g{PB + (size_t)l * T_ * PLE_, (const bf16_t*)(ws + WS_PLE) + (size_t)l * 1024 * 256, 256, 256, 256, 0, 0, 0}; Sched S; S.init(T_, 1024, 1, G, bx_());
          EpiPle E{EB}; gemm_phase(lds, g, S, E); }
        { Gemm g{X2, (const bf16_t*)(ws + WS_GATE) + (size_t)l * 1024 * 1024, 1024, 1024, 1024, 0, 0, 0}; Sched S; S.init(T_, 1024, 1, G, bx_());
          EpiGate E{EB, X2, X1, LO, st2, lds + 128 * 1024}; gemm_phase(lds, g, S, E); }
        GRID_BAR();
    }
    {
        FRESH_TID();
        const float* st = STATS + (size_t)(2 * NL_ - 1) * T_ * 8; const float* gam = p.in[24] + (size_t)(NL_ - 1) * 1024; const float* bet = p.in[25] + (size_t)(NL_ - 1) * 1024;
        for (size_t i = gtid; i < (size_t)T_ * D_ / 8; i += gsz) { const int row = (int)(i >> 7), c = (int)(i & 127) * 8; float mu, rstd; row_stats(st, row, true, mu, rstd);
            f32x4 va, vb; hl_load(X1, LO, row, c, va, vb);
            ((f32x4*)p.out)[2 * i] = (va - mu) * rstd * *(const f32x4*)(gam + c) + *(const f32x4*)(bet + c);
            ((f32x4*)p.out)[2 * i + 1] = (vb - mu) * rstd * *(const f32x4*)(gam + c + 4) + *(const f32x4*)(bet + c + 4); }
    }
}

extern "C" void kernel_launch(void* const* d_in, const int* in_sizes, int n_in, void* d_out, int out_size, void* d_ws, size_t ws_size, hipStream_t stream) {
    static int grid = 0;
    if (!grid) {
        int dev = 0, cus = 0, per_cu = 0;
        (void)hipGetDevice(&dev);
        (void)hipDeviceGetAttribute(&cus, hipDeviceAttributeMultiprocessorCount, dev);
        if (hipFuncSetAttribute((const void*)fwd_megakernel, hipFuncAttributeMaxDynamicSharedMemorySize, LDS_BYTES) != hipSuccess) fprintf(stderr, "hipFuncSetAttribute failed\n");
        (void)hipOccupancyMaxActiveBlocksPerMultiprocessor(&per_cu, (const void*)fwd_megakernel, 512, LDS_BYTES);
        if (per_cu < 1) fprintf(stderr, "occupancy query says %d blocks per CU\n", per_cu);
        if (ws_size < WS_END || n_in != 26 || out_size != T_ * D_) fprintf(stderr, "unexpected sizes: ws %zu n_in %d out %d\n", ws_size, n_in, out_size);
        grid = cus > 0 ? cus : 256;
    }
    if (hipMemsetAsync((unsigned char*)d_ws + WS_BAR, 0, XCD_BAR_WORDS * 4, stream) != hipSuccess) fprintf(stderr, "memset of the barrier words failed\n");
    Params p{};
    for (int i = 0; i < 26; ++i) p.in[i] = (const float*)d_in[i];
    p.out = (float*)d_out; p.ws = (unsigned char*)d_ws;
    void* args[] = {&p};
    hipError_t e = hipLaunchCooperativeKernel((const void*)fwd_megakernel, dim3(grid), dim3(512), args, LDS_BYTES, stream);
    if (e != hipSuccess) fprintf(stderr, "cooperative launch failed: %s (grid %d)\n", hipGetErrorString(e), grid);
}
```

```cpp
#include <hip/hip_runtime.h>
#include <hip/hip_cooperative_groups.h>
#include <cstdio>
namespace cg = cooperative_groups;

#define LAS __attribute__((address_space(3)))
typedef unsigned short bf16_t;
typedef short bf16x8 __attribute__((ext_vector_type(8)));
typedef float f32x4 __attribute__((ext_vector_type(4)));
typedef float f32x2 __attribute__((ext_vector_type(2)));
typedef unsigned u32x4 __attribute__((ext_vector_type(4)));

constexpr int T_ = 65536, D_ = 1024, H_ = 2816, NL_ = 4, SEQ_ = 2048, PLE_ = 256;
constexpr float ALPHA = 1.6817928305074290f;
constexpr float LN_EPS = 1e-5f;
constexpr int LDS_BYTES = 144 * 1024;

constexpr size_t MiB = (size_t)1 << 20;
constexpr size_t WS_WIN = 0, WS_WOUT = 8 * MiB, WS_GATE = 16 * MiB, WS_GLU = 24 * MiB, WS_PLE = 26 * MiB, WS_W13 = 28 * MiB, WS_W2 = 72 * MiB,
                 WS_WCOMB = 94 * MiB, WS_CVEC = 102 * MiB, WS_STATS = 103 * MiB, WS_LBP = 107 * MiB, WS_BBAR = 112 * MiB, WS_KMAT = 113 * MiB,
                 WS_PG = 121 * MiB, WS_LOC = 153 * MiB, WS_BAUG = 169 * MiB, WS_X1 = 241 * MiB, WS_X2 = 369 * MiB, WS_PB = 497 * MiB, WS_BIG = 625 * MiB,
                 WS_STATS2 = 977 * MiB, WS_END = 993 * MiB;
constexpr size_t BIG_AAUG = 0, BIG_Q = 72 * MiB, BIG_YG = 136 * MiB, BIG_MIX = 200 * MiB, BIG_E = 0;
constexpr size_t WS_BAR = WS_CVEC + 768 * 1024;
constexpr int CVEC_PER_LAYER = 2 * 1024 + 2 * 5632;

struct Params { const float* in[26]; float* out; unsigned char* ws; };

__device__ __forceinline__ bf16_t f2bf(float f) { unsigned u = __float_as_uint(f); u += 0x7FFFu + ((u >> 16) & 1u); return (bf16_t)(u >> 16); }
__device__ __forceinline__ float bf2f(bf16_t b) { return __uint_as_float(((unsigned)b) << 16); }
__device__ __forceinline__ unsigned cvt_pk(float lo, float hi) { unsigned r; asm volatile("v_cvt_pk_bf16_f32 %0, %1, %2" : "=v"(r) : "v"(lo), "v"(hi)); return r; }
__device__ __forceinline__ float bflo(unsigned w) { return __uint_as_float(w << 16); }
__device__ __forceinline__ float bfhi(unsigned w) { return __uint_as_float(w & 0xffff0000u); }
__device__ __forceinline__ u32x4 pack8(const f32x4 a, const f32x4 b) { u32x4 w; w.x = cvt_pk(a[0], a[1]); w.y = cvt_pk(a[2], a[3]); w.z = cvt_pk(b[0], b[1]); w.w = cvt_pk(b[2], b[3]); return w; }
__device__ __forceinline__ void unpack8(const u32x4 w, f32x4& a, f32x4& b) { a = (f32x4){bflo(w.x), bfhi(w.x), bflo(w.y), bfhi(w.y)}; b = (f32x4){bflo(w.z), bfhi(w.z), bflo(w.w), bfhi(w.w)}; }
typedef unsigned u32x2 __attribute__((ext_vector_type(2)));
__device__ __forceinline__ void hl_pack(const f32x4 va, const f32x4 vb, u32x4& w, u32x2& l) {
    const unsigned t0 = __float_as_uint(va[0]) + 0x8000u, t1 = __float_as_uint(va[1]) + 0x8000u, t2 = __float_as_uint(va[2]) + 0x8000u, t3 = __float_as_uint(va[3]) + 0x8000u;
    const unsigned t4 = __float_as_uint(vb[0]) + 0x8000u, t5 = __float_as_uint(vb[1]) + 0x8000u, t6 = __float_as_uint(vb[2]) + 0x8000u, t7 = __float_as_uint(vb[3]) + 0x8000u;
    w.x = __builtin_amdgcn_perm(t1, t0, 0x07060302u); w.y = __builtin_amdgcn_perm(t3, t2, 0x07060302u); w.z = __builtin_amdgcn_perm(t5, t4, 0x07060302u); w.w = __builtin_amdgcn_perm(t7, t6, 0x07060302u);
    l.x = __builtin_amdgcn_perm(t1, t0, 0x0c0c0501u) | __builtin_amdgcn_perm(t3, t2, 0x05010c0cu); l.y = __builtin_amdgcn_perm(t5, t4, 0x0c0c0501u) | __builtin_amdgcn_perm(t7, t6, 0x05010c0cu);
}
__device__ __forceinline__ size_t lo_off(int row, int pn, int wc, int fq) { return ((((size_t)row * 4 + pn) * 4 + wc) * 4 + fq) * 16; }
__device__ __forceinline__ void hl_decode(const u32x4 w, const u32x2 l, f32x4& va, f32x4& vb) {
    va[0] = __uint_as_float(__builtin_amdgcn_perm(w.x, l.x, 0x0504000cu) - 0x7f80u); va[1] = __uint_as_float(__builtin_amdgcn_perm(w.x, l.x, 0x0706010cu) - 0x7f80u);
    va[2] = __uint_as_float(__builtin_amdgcn_perm(w.y, l.x, 0x0504020cu) - 0x7f80u); va[3] = __uint_as_float(__builtin_amdgcn_perm(w.y, l.x, 0x0706030cu) - 0x7f80u);
    vb[0] = __uint_as_float(__builtin_amdgcn_perm(w.z, l.y, 0x0504000cu) - 0x7f80u); vb[1] = __uint_as_float(__builtin_amdgcn_perm(w.z, l.y, 0x0706010cu) - 0x7f80u);
    vb[2] = __uint_as_float(__builtin_amdgcn_perm(w.w, l.y, 0x0504020cu) - 0x7f80u); vb[3] = __uint_as_float(__builtin_amdgcn_perm(w.w, l.y, 0x0706030cu) - 0x7f80u);
}
__device__ __forceinline__ void hl_load(const bf16_t* X, const signed char* LO, int row, int col, f32x4& va, f32x4& vb) { const int c = col & 255;
    hl_decode(*(const u32x4*)(X + (size_t)row * 1024 + col), *(const u32x2*)(LO + lo_off(row, col >> 8, (c >> 5) & 3, (c >> 3) & 3) + (c >> 7) * 8), va, vb); }
__device__ __forceinline__ float sigmoidf_(float v) { return __builtin_amdgcn_rcpf(1.0f + __expf(-v)); }
__device__ __forceinline__ float gelu_tanh(float y) { const float z = 1.5957691216057308f * (y + 0.044715f * y * y * y); return y * sigmoidf_(z); }

#define XB_TMO      128
#define XB_XCNT(j)  (256  + 64 * (j))
#define XB_XSUB(j)  (1280 + 64 * (j))
#define XB_XGEN(j)  (2304 + 64 * (j))
#define XB_TOP      3328
#define XB_TOPGEN   3392
#define XCD_BAR_WORDS 3456
#define XB_SPIN_CAP (1u << 18)
__device__ __forceinline__ unsigned xb_ld(unsigned* p)              { return __hip_atomic_load(p, __ATOMIC_RELAXED, __HIP_MEMORY_SCOPE_AGENT); }
__device__ __forceinline__ unsigned xb_add(unsigned* p, unsigned v) { return __hip_atomic_fetch_add(p, v, __ATOMIC_RELAXED, __HIP_MEMORY_SCOPE_AGENT); }
__device__ __forceinline__ unsigned xb_xcc_id() { return (unsigned)__builtin_amdgcn_s_getreg((3 << 11) | 20) & 0xFu; }
#define XB_SPIN(cond, bar) do { unsigned _sp = 0; while (cond) { __builtin_amdgcn_s_sleep(1); \
    if ((++_sp & 255u) == 0u) { if (xb_ld(&(bar)[XB_TMO])) break; if (_sp > XB_SPIN_CAP) { atomicAdd(&(bar)[XB_TMO], 1u); break; } } } } while (0)
__device__ __forceinline__ int lane_id_() { int r; asm volatile("v_mbcnt_lo_u32_b32 %0, -1, 0\n\tv_mbcnt_hi_u32_b32 %0, -1, %0" : "=v"(r)); return r; }
struct XcdBarrier { unsigned* bar; unsigned x; volatile LAS unsigned* st; };
__device__ __forceinline__ XcdBarrier xcd_barrier_post(unsigned* bar, volatile LAS unsigned* st) {
    XcdBarrier b; b.bar = bar; b.x = xb_xcc_id(); b.st = st;
    if (threadIdx.x == 0) (void)xb_add(&bar[XB_XCNT(b.x)], 1u);
    return b;
}
__device__ __forceinline__ void xcd_barrier_complete(unsigned* bar, unsigned x, unsigned& nloc, unsigned& nx) {
    const unsigned G = gridDim.x * gridDim.y * gridDim.z;
    unsigned sum, cnt, mine, sp = 0u;
    for (;;) {
        sum = 0u; cnt = 0u; mine = 0u;
#pragma unroll
        for (unsigned j = 0; j < 16; ++j) { const unsigned c = xb_ld(&bar[XB_XCNT(j)]); sum += c; cnt += (c > 0u) ? 1u : 0u; mine = (j == x) ? c : mine; }
        if (sum == G) break;
        __builtin_amdgcn_s_sleep(1);
        if ((++sp & 255u) == 0u) { if (xb_ld(&bar[XB_TMO])) break; if (sp > XB_SPIN_CAP) { atomicAdd(&bar[XB_TMO], 1u); break; } }
    }
    nloc = mine > 0u ? mine : 1u; nx = cnt > 0u ? cnt : 1u;
}
__device__ __forceinline__ void xcd_barrier(const XcdBarrier& b, const bool t0) {
    asm volatile("s_waitcnt vmcnt(0)" ::: "memory");
    __syncthreads();
    if (t0) {
        unsigned* bar = b.bar;
        __builtin_amdgcn_s_waitcnt(0);
        unsigned nloc = b.st[0], nx = b.st[1];
        if (nloc == 0u) { xcd_barrier_complete(bar, b.x, nloc, nx); b.st[0] = nloc; b.st[1] = nx; }
        const unsigned old = xb_add(&bar[XB_XSUB(b.x)], 1u);
        const unsigned gen = old / nloc;
        if (old + 1u == (gen + 1u) * nloc) {
            __builtin_amdgcn_fence(__ATOMIC_RELEASE, "agent");
            asm volatile("s_waitcnt vmcnt(0)" ::: "memory");
            const unsigned og = xb_add(&bar[XB_TOP], 1u);
            const unsigned tg = og / nx;
            if (og + 1u == (tg + 1u) * nx) xb_add(&bar[XB_TOPGEN], 1u);
            else XB_SPIN(xb_ld(&bar[XB_TOPGEN]) == tg, bar);
            __builtin_amdgcn_fence(__ATOMIC_ACQUIRE, "agent");
            xb_add(&bar[XB_XGEN(b.x)], 1u);
            asm volatile("s_waitcnt vmcnt(0)" ::: "memory");
        } else {
            XB_SPIN(xb_ld(&bar[XB_XGEN(b.x)]) == gen, bar);
            __builtin_amdgcn_fence(__ATOMIC_ACQUIRE, "agent");
            asm volatile("s_waitcnt vmcnt(0)" ::: "memory");
        }
    }
    __syncthreads();
}

constexpr int BM = 256, BK = 64, HALF = 128, HTB = HALF * BK * 2, NXCD = 8, WGM = 8;
__device__ __forceinline__ int lds_byte(int r, int c) { const int st = (r >> 4) * 2 + (c >> 5), rr = r & 15, cc = c & 31, ob = rr * 64 + cc * 2; return st * 1024 + (ob ^ (((ob >> 9) & 1) << 5)); }
__device__ __forceinline__ void stage_rc(int b, int& R, int& C) { const int st = b / 1024, sb = b % 1024, swz = sb ^ (((sb >> 9) & 1) << 5); R = (st >> 1) * 16 + swz / 64; C = (st & 1) * 32 + (swz % 64) / 2; }
__device__ __forceinline__ int perm32(int rho) { const int n = rho >> 4, i = rho & 15; return 8 * (i >> 2) + 4 * n + (i & 3); }

struct Unit { int pm, pn, g; };
struct Gemm { const bf16_t* A; const bf16_t* B; int lda, ldb, K; size_t batchA, batchB; int hzero; };
struct Sched {
    int nM, nN, per, tot, G, c;
    __device__ void init(int M, int N, int nG, int G_, int c_) { nM = M / BM; nN = N / BM; per = nM * nN; tot = per * nG; G = G_; c = c_; }
    __device__ bool next(int i, Unit& u) const {
        const long L = (long)i * G + c; if (L >= tot) return false;
        int wgid = (int)L; { const int q = tot / NXCD, r = tot % NXCD, xcd = wgid % NXCD, off = wgid / NXCD; wgid = (xcd < r ? xcd * (q + 1) : r * (q + 1) + (xcd - r) * q) + off; }
        u.g = wgid / per; const int w = wgid % per;
        const int nig = WGM * nN, gid = w / nig, fm = gid * WGM, gsz = (nM - fm) < WGM ? (nM - fm) : WGM;
        u.pm = fm + ((w % nig) % gsz); u.pn = (w % nig) / gsz; return true;
    }
};

template <class Epi>
__device__ __forceinline__ void gemm_phase(LAS unsigned char* lds, const Gemm g, const Sched& S, const Epi& E, const int wave) {
    int tid = wave * 64 + lane_id_(); asm volatile("" : "+v"(tid));
    const int wid = wave, lane = tid & 63, wr = wid >> 2, wc = wid & 3, fr = lane & 15, fq = lane >> 4;
    const int nt = g.K / BK;
    unsigned voffA[2], voffB[2];
#pragma unroll
    for (int i = 0; i < 2; ++i) { int R, C; stage_rc(tid * 16 + i * 8192, R, C); const int Rb = (R & ~31) + perm32(R & 31);
        voffA[i] = (unsigned)(R * g.lda + C) * 2u; voffB[i] = (unsigned)(Rb * g.ldb + C) * 2u; }
    const size_t kstep = (size_t)(BK * 2);
    const size_t hstepA = (size_t)HALF * g.lda * 2, hstepB = g.hzero ? (size_t)0 : (size_t)HALF * g.ldb * 2;
    const size_t tstepA = 2 * (size_t)HALF * g.lda * 2, tstepB = 2 * (size_t)HALF * g.ldb * 2;
    const unsigned ldsw = (unsigned)wid * 1024u;
    const int aoff = lds_byte(wr * 64 + fr, fq * 8), boff = lds_byte(wc * 32 + fr, fq * 8);
#define G_SA(b, h) (((b) * 2 + (h)) * HTB)
#define G_SB(b, h) ((4 + (b) * 2 + (h)) * HTB)
#define G_STAGE(bufoff, gbase, voff) do { _Pragma("unroll") for (int _i = 0; _i < 2; ++_i) \
        __builtin_amdgcn_global_load_lds((const unsigned*)((const char*)(gbase) + (voff)[_i]), (LAS unsigned*)(lds + (bufoff) + ldsw + _i * 8192), 16, 0, 0); } while (0)
#define G_LDA(dst, b, h) do { _Pragma("unroll") for (int m = 0; m < 4; ++m) _Pragma("unroll") for (int k = 0; k < 2; ++k) dst[m][k] = *(const LAS bf16x8*)(lds + G_SA(b, h) + aoff + m * 2048 + k * 1024); } while (0)
#define G_LDB(dst, b, h) do { _Pragma("unroll") for (int n = 0; n < 2; ++n) _Pragma("unroll") for (int k = 0; k < 2; ++k) dst[n][k] = *(const LAS bf16x8*)(lds + G_SB(b, h) + boff + n * 2048 + k * 1024); } while (0)
#define G_MMA(ai, bj, At, Bt) do { __builtin_amdgcn_s_setprio(1); _Pragma("unroll") for (int m = 0; m < 4; ++m) _Pragma("unroll") for (int n = 0; n < 2; ++n) _Pragma("unroll") for (int k = 0; k < 2; ++k) \
        acc[ai][bj][m][n] = __builtin_amdgcn_mfma_f32_16x16x32_bf16(Bt[n][k], At[m][k], acc[ai][bj][m][n], 0, 0, 0); __builtin_amdgcn_s_setprio(0); } while (0)
#define G_WAIT_V(n) asm volatile("s_waitcnt vmcnt(" #n ")" ::: "memory")
#define G_WAIT_L(n) asm volatile("s_waitcnt lgkmcnt(" #n ")" ::: "memory")
#define G_BAR __builtin_amdgcn_s_barrier()
#define G_SCHED __builtin_amdgcn_sched_barrier(0)
    Unit cur, nxt; int ui = 0;
    if (!S.next(0, cur)) return;
    f32x4 acc[2][2][4][2];
#pragma unroll
    for (int a = 0; a < 2; ++a)
#pragma unroll
        for (int b = 0; b < 2; ++b)
#pragma unroll
            for (int m = 0; m < 4; ++m)
#pragma unroll
                for (int n = 0; n < 2; ++n) acc[a][b][m][n] = (f32x4){0.f, 0.f, 0.f, 0.f};
    bf16x8 At[4][2], B0[2][2], B1[2][2];
    const char* cA = (const char*)g.A + (size_t)cur.g * g.batchA + (size_t)cur.pm * tstepA; const char* cB = (const char*)g.B + (size_t)cur.g * g.batchB + (size_t)cur.pn * tstepB;
    G_STAGE(G_SB(0, 0), cB, voffB); G_STAGE(G_SA(0, 0), cA, voffA); G_STAGE(G_SB(0, 1), cB + hstepB, voffB); G_STAGE(G_SA(0, 1), cA + hstepA, voffA);
    if (wr == 1) G_BAR;
    G_WAIT_V(4); G_BAR;
    G_STAGE(G_SB(1, 0), cB + kstep, voffB); G_STAGE(G_SA(1, 0), cA + kstep, voffA); G_STAGE(G_SB(1, 1), cB + hstepB + kstep, voffB);
    G_WAIT_V(6); G_BAR;
    for (;;) {
        const bool has_next = S.next(ui + 1, nxt);
        const char* nA = has_next ? (const char*)g.A + (size_t)nxt.g * g.batchA + (size_t)nxt.pm * tstepA : cA;
        const char* nB = has_next ? (const char*)g.B + (size_t)nxt.g * g.batchB + (size_t)nxt.pn * tstepB : cB;
        for (int t = 0; t < nt; t += 2) {
            const bool last = (t == nt - 2);
            const char* a1 = cA + (size_t)(t + 1) * kstep;
            const char* a2 = last ? nA : cA + (size_t)(t + 2) * kstep; const char* b2 = last ? nB : cB + (size_t)(t + 2) * kstep;
            const char* a3 = a2 + kstep; const char* b3 = b2 + kstep;
            G_LDB(B0, 0, 0); G_SCHED; G_LDA(At, 0, 0); G_STAGE(G_SA(1, 1), a1 + hstepA, voffA);
            G_WAIT_L(8); G_BAR; G_WAIT_L(0); G_MMA(0, 0, At, B0); G_BAR; G_SCHED;
            G_LDB(B1, 0, 1); G_STAGE(G_SB(0, 0), b2, voffB);
            G_BAR; G_WAIT_L(0); G_MMA(0, 1, At, B1); G_BAR;
            G_LDA(At, 0, 1); G_STAGE(G_SA(0, 0), a2, voffA);
            G_BAR; G_WAIT_L(0); G_MMA(1, 0, At, B0); G_BAR; G_SCHED;
            G_STAGE(G_SB(0, 1), b2 + hstepB, voffB);
            G_WAIT_V(6); G_BAR; G_MMA(1, 1, At, B1); G_BAR;
            G_LDB(B0, 1, 0); G_SCHED; G_LDA(At, 1, 0); G_STAGE(G_SA(0, 1), a2 + hstepA, voffA);
            G_WAIT_L(8); G_BAR; G_WAIT_L(0); G_MMA(0, 0, At, B0); G_BAR; G_SCHED;
            G_LDB(B1, 1, 1); G_STAGE(G_SB(1, 0), b3, voffB);
            G_BAR; G_WAIT_L(0); G_MMA(0, 1, At, B1); G_BAR;
            G_LDA(At, 1, 1); G_STAGE(G_SA(1, 0), a3, voffA);
            G_BAR; G_WAIT_L(0); G_MMA(1, 0, At, B0); G_BAR; G_SCHED;
            G_STAGE(G_SB(1, 1), b3 + hstepB, voffB);
            G_WAIT_V(6); G_BAR; G_MMA(1, 1, At, B1); G_BAR;
        }
        { int fr2 = fr, fq2 = fq; asm volatile("" : "+v"(fr2), "+v"(fq2));
          E(acc, cur, wr, wc, fr2, fq2); }
        if (!has_next) break;
#pragma unroll
        for (int a = 0; a < 2; ++a)
#pragma unroll
            for (int b = 0; b < 2; ++b)
#pragma unroll
                for (int m = 0; m < 4; ++m)
#pragma unroll
                    for (int n = 0; n < 2; ++n) acc[a][b][m][n] = (f32x4){0.f, 0.f, 0.f, 0.f};
        cur = nxt; cA = nA; cB = nB; ++ui;
    }
    G_WAIT_V(0);
    if (wr == 0) G_BAR;
    G_BAR;
#undef G_SA
#undef G_SB
#undef G_STAGE
#undef G_LDA
#undef G_LDB
#undef G_MMA
#undef G_WAIT_V
#undef G_WAIT_L
#undef G_BAR
#undef G_SCHED
}

typedef f32x4 Acc[2][2][4][2];
__device__ __forceinline__ void row_stats(const float* st, int row, bool ln, float& mu, float& rstd) {
    if (ln) { const f32x4 a = *(const f32x4*)(st + 8 * (size_t)row), b = *(const f32x4*)(st + 8 * (size_t)row + 4); const float sx = (a[0] + a[2]) + (b[0] + b[2]), sy = (a[1] + a[3]) + (b[1] + b[3]);
        mu = sx * (1.0f / 1024.0f); const float var = sy * (1.0f / 1024.0f) - mu * mu; rstd = __builtin_amdgcn_rsqf(var + LN_EPS); }
    else { mu = 0.f; rstd = 1.f; }
}
#define ROW_STATS8(st, lnflag, MU, RS) float MU[8], RS[8]; { f32x4 sa_[8], sb_[8]; \
    _Pragma("unroll") for (int r_ = 0; r_ < 8; ++r_) { const int row_ = ROW_OF(u, r_ >> 2, r_ & 3); if (lnflag) { sa_[r_] = *(const f32x4*)((st) + 8 * (size_t)row_); sb_[r_] = *(const f32x4*)((st) + 8 * (size_t)row_ + 4); } } \
    _Pragma("unroll") for (int r_ = 0; r_ < 8; ++r_) { if (lnflag) { const float sx_ = (sa_[r_][0] + sa_[r_][2]) + (sb_[r_][0] + sb_[r_][2]), sy_ = (sa_[r_][1] + sa_[r_][3]) + (sb_[r_][1] + sb_[r_][3]); \
        MU[r_] = sx_ * (1.0f / 1024.0f); RS[r_] = __builtin_amdgcn_rsqf(sy_ * (1.0f / 1024.0f) - MU[r_] * MU[r_] + LN_EPS); } else { MU[r_] = 0.f; RS[r_] = 1.f; } \
        asm volatile("" : "+v"(MU[r_]), "+v"(RS[r_])); } asm volatile("" ::: "memory"); __builtin_amdgcn_sched_barrier(0); }
#define EPI_ROWS(ai, m) for (int ai = 0; ai < 2; ++ai) for (int m = 0; m < 4; ++m)
#define ROW_OF(u, ai, m) ((u).pm * BM + (ai) * HALF + wr * 64 + (m) * 16 + fr)
#define COL_OF(u, bj) ((u).pn * BM + (bj) * HALF + wc * 32 + 8 * fq)

#define ROWLOOP _Pragma("unroll") for (int ai = 0; ai < 2; ++ai) _Pragma("unroll") for (int m = 0; m < 4; ++m)
#define BJLOOP _Pragma("unroll") for (int bj = 0; bj < 2; ++bj)
#define PIN(ai, m) asm volatile("" : "+v"(acc[ai][0][m][0]), "+v"(acc[ai][0][m][1]), "+v"(acc[ai][1][m][0]), "+v"(acc[ai][1][m][1]))
#define FENCE1 do { asm volatile("" ::: "memory"); __builtin_amdgcn_sched_barrier(0); } while (0)
#define FENCE2 do { if (m & 1) { asm volatile("" ::: "memory"); __builtin_amdgcn_sched_barrier(0); } } while (0)

struct EpiIn {
    const float* st; const float* c1; const float* c2; bf16_t* Q; bf16_t* Aaug; int ln;
    __device__ __forceinline__ void operator()(Acc& acc, const Unit& u, int wr, int wc, int fr, int fq) const {
        {
            ROW_STATS8(st, ln, mu8, rs8);
            f32x4 k1a[2], k1b[2], k2a[2], k2b[2]; const f32x4 z = {0.f, 0.f, 0.f, 0.f};
            BJLOOP { const int c0 = COL_OF(u, bj); k1a[bj] = ln ? *(const f32x4*)(c1 + c0) : z; k1b[bj] = ln ? *(const f32x4*)(c1 + c0 + 4) : z; k2a[bj] = ln ? *(const f32x4*)(c2 + c0) : z; k2b[bj] = ln ? *(const f32x4*)(c2 + c0 + 4) : z; }
            ROWLOOP { const float mu = mu8[ai * 4 + m], rstd = rs8[ai * 4 + m];
                BJLOOP { acc[ai][bj][m][0] = (acc[ai][bj][m][0] - mu * k1a[bj]) * rstd + k2a[bj]; acc[ai][bj][m][1] = (acc[ai][bj][m][1] - mu * k1b[bj]) * rstd + k2b[bj]; }
                PIN(ai, m); FENCE2; }
        }
        asm volatile("" : "+v"(fr), "+v"(fq) :: "memory");
        BJLOOP { const int c0 = COL_OF(u, bj);
            ROWLOOP { const int row = ROW_OF(u, ai, m); const u32x4 w = pack8(acc[ai][bj][m][0], acc[ai][bj][m][1]);
                if (c0 < 512) *(u32x4*)(Q + (size_t)row * 512 + c0) = w;
                else { const int cc = c0 - 512, gg = cc >> 4, c = cc & 15; *(u32x4*)(Aaug + ((size_t)gg * 1024 + (row >> 6)) * 1152 + (row & 63) * 16 + c) = w; } FENCE2; } }
    }
};
struct EpiLoc {
    float* Loc;
    __device__ __forceinline__ void operator()(Acc& acc, const Unit& u, int wr, int wc, int fr, int fq) const {
        const int c0 = wc * 32 + 8 * fq;
        ROWLOOP { const int row = ROW_OF(u, ai, m); float* dst = Loc + ((size_t)u.g * 1024 + row) * 128 + c0;
            *(f32x4*)dst = acc[ai][0][m][0]; *(f32x4*)(dst + 4) = acc[ai][0][m][1]; FENCE2; }
    }
};
struct EpiSsm {
    const bf16_t* Aaug; const float* dvec; bf16_t* YG;
    __device__ __forceinline__ void operator()(Acc& acc, const Unit& u, int wr, int wc, int fr, int fq) const {
        {
            f32x4 da[2], db[2]; u32x4 uw[2][2];
            BJLOOP { const int c = COL_OF(u, bj) & 15; da[bj] = *(const f32x4*)(dvec + u.g * 16 + c); db[bj] = *(const f32x4*)(dvec + u.g * 16 + c + 4); }
#define SSM_LOAD(r, s) do { const int row_ = ROW_OF(u, (r) >> 2, (r) & 3); BJLOOP uw[s][bj] = *(const u32x4*)(Aaug + ((size_t)u.g * 1024 + row_) * 1152 + COL_OF(u, bj)); } while (0)
            SSM_LOAD(0, 0);
#pragma unroll
            for (int r = 0; r < 8; ++r) {
                if (r + 1 < 8) SSM_LOAD(r + 1, (r + 1) & 1);
                __builtin_amdgcn_sched_barrier(0);
                const int ai = r >> 2, m = r & 3, s = r & 1;
                BJLOOP { f32x4 ua, ub; unpack8(uw[s][bj], ua, ub);
                    f32x4 ya = acc[ai][bj][m][0] + da[bj] * ua, yb = acc[ai][bj][m][1] + db[bj] * ub;
#pragma unroll
                    for (int j = 0; j < 4; ++j) { ya[j] = gelu_tanh(ya[j]); yb[j] = gelu_tanh(yb[j]); }
                    acc[ai][bj][m][0] = ya; acc[ai][bj][m][1] = yb; }
                PIN(ai, m); asm volatile("" ::: "memory"); __builtin_amdgcn_sched_barrier(0);
            }
#undef SSM_LOAD
        }
        asm volatile("" : "+v"(fr), "+v"(fq) :: "memory");
        BJLOOP { const int c0 = COL_OF(u, bj), tl = c0 >> 4, c = c0 & 15;
            ROWLOOP { const int row = ROW_OF(u, ai, m); *(u32x4*)(YG + ((size_t)row * 64 + tl) * 512 + u.g * 16 + c) = pack8(acc[ai][bj][m][0], acc[ai][bj][m][1]); FENCE2; } }
    }
};
struct EpiGlu {
    const bf16_t* YG; const float* bias; bf16_t* MIX;
    __device__ __forceinline__ void operator()(Acc& acc, const Unit& u, int wr, int wc, int fr, int fq) const {
        {
            f32x4 ba[2], bb[2]; u32x4 yw[2][2];
            BJLOOP { const int c0 = COL_OF(u, bj); ba[bj] = *(const f32x4*)(bias + c0); bb[bj] = *(const f32x4*)(bias + c0 + 4); }
#define GLU_LOAD(r, s) do { const int row_ = ROW_OF(u, (r) >> 2, (r) & 3); BJLOOP yw[s][bj] = *(const u32x4*)(YG + (size_t)row_ * 512 + COL_OF(u, bj)); } while (0)
            GLU_LOAD(0, 0);
#pragma unroll
            for (int r = 0; r < 8; ++r) {
                if (r + 1 < 8) GLU_LOAD(r + 1, (r + 1) & 1);
                __builtin_amdgcn_sched_barrier(0);
                const int ai = r >> 2, m = r & 3, s = r & 1;
                BJLOOP { f32x4 ya, yb; unpack8(yw[s][bj], ya, yb);
                    f32x4 ga = acc[ai][bj][m][0] + ba[bj], gb = acc[ai][bj][m][1] + bb[bj];
#pragma unroll
                    for (int j = 0; j < 4; ++j) { ga[j] = ya[j] * sigmoidf_(ga[j]); gb[j] = yb[j] * sigmoidf_(gb[j]); }
                    acc[ai][bj][m][0] = ga; acc[ai][bj][m][1] = gb; }
                PIN(ai, m); asm volatile("" ::: "memory"); __builtin_amdgcn_sched_barrier(0);
            }
#undef GLU_LOAD
        }
        asm volatile("" : "+v"(fr), "+v"(fq) :: "memory");
        BJLOOP { const int c0 = COL_OF(u, bj);
            ROWLOOP { const int row = ROW_OF(u, ai, m); *(u32x4*)(MIX + (size_t)row * 1024 + 512 + c0) = pack8(acc[ai][bj][m][0], acc[ai][bj][m][1]); FENCE2; } }
    }
};
__device__ __forceinline__ void stats_publish(LAS unsigned char* red, float* st, const Acc& acc, const Unit& u, int wr, int wc, int fr, int fq) {
    LAS f32x2* R = (LAS f32x2*)red + wr * 512;
#pragma unroll
    for (int ai = 0; ai < 2; ++ai)
#pragma unroll
        for (int m = 0; m < 4; ++m) { float s = 0.f, ss = 0.f;
#pragma unroll
            for (int bj = 0; bj < 2; ++bj) { const f32x4 va = acc[ai][bj][m][0], vb = acc[ai][bj][m][1];
                s += (va[0] + va[1]) + (va[2] + va[3]) + (vb[0] + vb[1]) + (vb[2] + vb[3]);
                ss += (va[0] * va[0] + va[1] * va[1]) + (va[2] * va[2] + va[3] * va[3]) + (vb[0] * vb[0] + vb[1] * vb[1]) + (vb[2] * vb[2] + vb[3] * vb[3]); }
            s += __shfl_xor(s, 16); s += __shfl_xor(s, 32); ss += __shfl_xor(ss, 16); ss += __shfl_xor(ss, 32);
            if (fq == 0) R[((ai * 4 + m) * 16 + fr) * 4 + wc] = (f32x2){s, ss}; }
    asm volatile("s_waitcnt lgkmcnt(0)" ::: "memory"); __builtin_amdgcn_s_barrier(); asm volatile("" ::: "memory");
    const int lane = fq * 16 + fr;
    if (lane < 32) { const int rl = wc * 32 + lane; const f32x2 a = R[rl * 4], b = R[rl * 4 + 1], c = R[rl * 4 + 2], d = R[rl * 4 + 3];
        const int ai = rl >> 6, m = (rl >> 4) & 3, f = rl & 15; const int row = u.pm * BM + ai * HALF + wr * 64 + m * 16 + f;
        *(f32x2*)(st + ((size_t)row * 4 + u.pn) * 2) = (f32x2){(a.x + b.x) + (c.x + d.x), (a.y + b.y) + (c.y + d.y)}; }
}
template <bool STATS, bool SRC32>
struct EpiRes {
    const float* src32; const bf16_t* srcX; const float* st_in; const float* gam; const float* bet; int ln; bf16_t* X; signed char* LO; float* st_out; LAS unsigned char* red;
    __device__ __forceinline__ void operator()(Acc& acc, const Unit& u, int wr, int wc, int fr, int fq) const {
        ROW_STATS8(st_in, (!SRC32), mu8, rs8);
        f32x4 ga[2], gb[2], ba[2], bb[2];
        BJLOOP { const int c0 = COL_OF(u, bj);
            if (ln) { ga[bj] = *(const f32x4*)(gam + c0); gb[bj] = *(const f32x4*)(gam + c0 + 4); ba[bj] = *(const f32x4*)(bet + c0); bb[bj] = *(const f32x4*)(bet + c0 + 4); } }
        if (SRC32) {
        ROWLOOP { const int row = ROW_OF(u, ai, m); float mu, rstd; row_stats(st_in, row, ln, mu, rstd);
            BJLOOP { const size_t off = (size_t)row * 1024 + COL_OF(u, bj);
                f32x4 ha = *(const f32x4*)(src32 + off), hb = *(const f32x4*)(src32 + off + 4);
                if (ln) { ha = (ha - mu) * rstd * ga[bj] + ba[bj]; hb = (hb - mu) * rstd * gb[bj] + bb[bj]; }
                acc[ai][bj][m][0] += ALPHA * ha; acc[ai][bj][m][1] += ALPHA * hb; }
            PIN(ai, m); FENCE2; }
        } else {
            u32x4 hi[2][2], lo4[2];
#define RES_LOAD(r, s) do { const int row_ = ROW_OF(u, (r) >> 2, (r) & 3); \
                lo4[s] = *(const u32x4*)(LO + lo_off(row_, u.pn, wc, fq)); BJLOOP { const size_t off_ = (size_t)row_ * 1024 + COL_OF(u, bj); hi[s][bj] = *(const u32x4*)(srcX + off_); } } while (0)
            RES_LOAD(0, 0);
#pragma unroll
            for (int r = 0; r < 8; ++r) {
                if (r + 1 < 8) RES_LOAD(r + 1, (r + 1) & 1);
                __builtin_amdgcn_sched_barrier(0);
                const int ai = r >> 2, m = r & 3, s = r & 1;
                const float mu = mu8[r], rstd = rs8[r];
                BJLOOP { f32x4 ha, hb; hl_decode(hi[s][bj], bj ? (u32x2){lo4[s].z, lo4[s].w} : (u32x2){lo4[s].x, lo4[s].y}, ha, hb);
                    ha = (ha - mu) * rstd * ga[bj] + ba[bj]; hb = (hb - mu) * rstd * gb[bj] + bb[bj];
                    acc[ai][bj][m][0] += ALPHA * ha; acc[ai][bj][m][1] += ALPHA * hb; }
                PIN(ai, m); asm volatile("" ::: "memory"); __builtin_amdgcn_sched_barrier(0);
            }
#undef RES_LOAD
        }
        asm volatile("" : "+v"(fr), "+v"(fq) :: "memory");
        ROWLOOP { const int row = ROW_OF(u, ai, m);
            { u32x4 w0, w1; u32x2 l0, l1; hl_pack(acc[ai][0][m][0], acc[ai][0][m][1], w0, l0); hl_pack(acc[ai][1][m][0], acc[ai][1][m][1], w1, l1);
              *(u32x4*)(X + (size_t)row * 1024 + COL_OF(u, 0)) = w0; *(u32x4*)(X + (size_t)row * 1024 + COL_OF(u, 1)) = w1; *(u32x4*)(LO + lo_off(row, u.pn, wc, fq)) = (u32x4){l0.x, l0.y, l1.x, l1.y}; }
            FENCE1; }
        if (STATS) stats_publish(red, st_out, acc, u, wr, wc, fr, fq);
    }
};
struct EpiFfn {
    const float* st; const float* c1; const float* c2; bf16_t* HID; LAS unsigned char* cache;
    __device__ __forceinline__ void operator()(Acc& acc, const Unit& u, int wr, int wc, int fr, int fq) const {
        const int r0 = u.pn * 256 + wc * 32 + 8 * fq, hc = u.pn * 128 + wc * 32 + 8 * fq;
        LAS f32x2* SC = (LAS f32x2*)cache; LAS int* TAG = (LAS int*)(cache + 2048) + (wr * 4 + wc);
        float mu8[8], rs8[8];
        if (__builtin_amdgcn_readfirstlane(*TAG) != u.pm + 1) {
            ROW_STATS8(st, true, mu8g, rs8g);
#pragma unroll
            for (int r = 0; r < 8; ++r) { mu8[r] = mu8g[r]; rs8[r] = rs8g[r]; if (fq == 0) SC[(r >> 2) * 128 + wr * 64 + (r & 3) * 16 + fr] = (f32x2){mu8g[r], rs8g[r]}; }
            if (fq == 0 && fr == 0) *TAG = u.pm + 1;
        } else {
#pragma unroll
            for (int r = 0; r < 8; ++r) { const f32x2 v = SC[(r >> 2) * 128 + wr * 64 + (r & 3) * 16 + fr]; mu8[r] = v.x; rs8[r] = v.y; }
        }
        const f32x4 g1a = *(const f32x4*)(c1 + r0), g1b = *(const f32x4*)(c1 + r0 + 4), g2a = *(const f32x4*)(c2 + r0), g2b = *(const f32x4*)(c2 + r0 + 4);
        const f32x4 u1a = *(const f32x4*)(c1 + r0 + 128), u1b = *(const f32x4*)(c1 + r0 + 132), u2a = *(const f32x4*)(c2 + r0 + 128), u2b = *(const f32x4*)(c2 + r0 + 132);
        ROWLOOP { const float mu = mu8[ai * 4 + m], rstd = rs8[ai * 4 + m];
            f32x4 ga = (acc[ai][0][m][0] - mu * g1a) * rstd + g2a, gb = (acc[ai][0][m][1] - mu * g1b) * rstd + g2b;
            const f32x4 ua = (acc[ai][1][m][0] - mu * u1a) * rstd + u2a, ub = (acc[ai][1][m][1] - mu * u1b) * rstd + u2b;
#pragma unroll
            for (int j = 0; j < 4; ++j) { ga[j] = ga[j] * sigmoidf_(ga[j]) * ua[j]; gb[j] = gb[j] * sigmoidf_(gb[j]) * ub[j]; }
            acc[ai][0][m][0] = ga; acc[ai][0][m][1] = gb; PIN(ai, m); FENCE2; }
        asm volatile("" : "+v"(fr), "+v"(fq) :: "memory");
        ROWLOOP { const int row = ROW_OF(u, ai, m); *(u32x4*)(HID + (size_t)row * H_ + hc) = pack8(acc[ai][0][m][0], acc[ai][0][m][1]); FENCE2; }
    }
};
struct EpiPle {
    bf16_t* E;
    __device__ __forceinline__ void operator()(Acc& acc, const Unit& u, int wr, int wc, int fr, int fq) const {
        ROWLOOP { const int row = ROW_OF(u, ai, m);
            BJLOOP *(u32x4*)(E + (size_t)row * 1024 + COL_OF(u, bj)) = pack8(acc[ai][bj][m][0], acc[ai][bj][m][1]);
            FENCE2; }
    }
};
struct EpiGate {
    const bf16_t* E; const bf16_t* Xr; bf16_t* X; signed char* LO; float* st_out; LAS unsigned char* red;
    __device__ __forceinline__ void operator()(Acc& acc, const Unit& u, int wr, int wc, int fr, int fq) const {
        {
            u32x4 hi[2][2], ee[2][2], lo4[2];
#define GATE_LOAD(r, s) do { const int row_ = ROW_OF(u, (r) >> 2, (r) & 3); \
                lo4[s] = *(const u32x4*)(LO + lo_off(row_, u.pn, wc, fq)); BJLOOP { const size_t off_ = (size_t)row_ * 1024 + COL_OF(u, bj); hi[s][bj] = *(const u32x4*)(Xr + off_); ee[s][bj] = *(const u32x4*)(E + off_); } } while (0)
            GATE_LOAD(0, 0);
#pragma unroll
            for (int r = 0; r < 8; ++r) {
                if (r + 1 < 8) GATE_LOAD(r + 1, (r + 1) & 1);
                __builtin_amdgcn_sched_barrier(0);
                const int ai = r >> 2, m = r & 3, s = r & 1;
                BJLOOP { f32x4 ra, rb; hl_decode(hi[s][bj], bj ? (u32x2){lo4[s].z, lo4[s].w} : (u32x2){lo4[s].x, lo4[s].y}, ra, rb); f32x4 ea, eb; unpack8(ee[s][bj], ea, eb);
                    f32x4 va, vb;
#pragma unroll
                    for (int j = 0; j < 4; ++j) { va[j] = ra[j] + ea[j] * sigmoidf_(acc[ai][bj][m][0][j]); vb[j] = rb[j] + eb[j] * sigmoidf_(acc[ai][bj][m][1][j]); }
                    acc[ai][bj][m][0] = va; acc[ai][bj][m][1] = vb; }
                PIN(ai, m); asm volatile("" ::: "memory"); __builtin_amdgcn_sched_barrier(0);
            }
#undef GATE_LOAD
        }
        asm volatile("" : "+v"(fr), "+v"(fq) :: "memory");
        ROWLOOP { const int row = ROW_OF(u, ai, m);
            { u32x4 w0, w1; u32x2 l0, l1; hl_pack(acc[ai][0][m][0], acc[ai][0][m][1], w0, l0); hl_pack(acc[ai][1][m][0], acc[ai][1][m][1], w1, l1);
              *(u32x4*)(X + (size_t)row * 1024 + COL_OF(u, 0)) = w0; *(u32x4*)(X + (size_t)row * 1024 + COL_OF(u, 1)) = w1; *(u32x4*)(LO + lo_off(row, u.pn, wc, fq)) = (u32x4){l0.x, l0.y, l1.x, l1.y}; }
            FENCE1; }
        stats_publish(red, st_out, acc, u, wr, wc, fr, fq);
    }
};

__device__ void transpose_job(float* tile  , const float* src, int lds_, int K, int N, const float* scale, bf16_t* dst, int mode, int off, int& base,
                              const float* bet, float* c1, float* c2, int coff, const int tid) {
    const int G = gridDim.x, nkt = K / 64, nnt = N / 64, ntile = nkt * nnt;
    int first = ((int)blockIdx.x - base) % G; if (first < 0) first += G;
    for (int t = first; t < ntile; t += G) {
        const int kt = t / nnt, ntl = t % nnt;
        __syncthreads();
#pragma unroll
        for (int pss = 0; pss < 2; ++pss) { const int kk = pss * 32 + (tid >> 4), n4 = (tid & 15) * 4;
            const f32x4 v = *(const f32x4*)(src + (size_t)(kt * 64 + kk) * lds_ + ntl * 64 + n4);
            tile[(n4 + 0) * 65 + kk] = v[0]; tile[(n4 + 1) * 65 + kk] = v[1]; tile[(n4 + 2) * 65 + kk] = v[2]; tile[(n4 + 3) * 65 + kk] = v[3]; }
        __syncthreads();
        { const int n = tid >> 3, k8 = (tid & 7) * 8; const float* r = tile + n * 65 + k8;
            float sc[8];
#pragma unroll
            for (int j = 0; j < 8; ++j) sc[j] = scale ? scale[kt * 64 + k8 + j] : 1.0f;
            u32x4 w; w.x = cvt_pk(r[0] * sc[0], r[1] * sc[1]); w.y = cvt_pk(r[2] * sc[2], r[3] * sc[3]); w.z = cvt_pk(r[4] * sc[4], r[5] * sc[5]); w.w = cvt_pk(r[6] * sc[6], r[7] * sc[7]);
            const int ng = ntl * 64 + n; const int drow = mode ? ((ng >> 7) * 256 + (ng & 127) + off) : ng;
            *(u32x4*)(dst + (size_t)drow * K + kt * 64 + k8) = w;
            if (c1) {
                float s1 = (bflo(w.x) + bfhi(w.x)) + (bflo(w.y) + bfhi(w.y)) + (bflo(w.z) + bfhi(w.z)) + (bflo(w.w) + bfhi(w.w)), s2 = 0.f;
#pragma unroll
                for (int j = 0; j < 8; ++j) s2 += r[j] * bet[kt * 64 + k8 + j];
                s1 += __shfl_xor(s1, 1); s1 += __shfl_xor(s1, 2); s1 += __shfl_xor(s1, 4); s2 += __shfl_xor(s2, 1); s2 += __shfl_xor(s2, 2); s2 += __shfl_xor(s2, 4);
                if ((tid & 7) == 0) { atomicAdd(c1 + coff + drow, s1); atomicAdd(c2 + coff + drow, s2); } }
        }
    }
    base = (base + ntile) % G;
}

template <int W>
__device__ __forceinline__ void fir_item(const bf16_t* __restrict__ qb, bf16_t* __restrict__ mb, int t0, const f32x4 ba, const f32x4 bb, const f32x4 sa, const f32x4 sb) {
    constexpr int TS = 8, NR = W - 1 + TS;
    u32x4 raw[NR];
#pragma unroll
    for (int r = 0; r < NR; ++r) { const int t = t0 - (W - 1) + r; raw[r] = (t >= 0) ? *(const u32x4*)(qb + (size_t)t * 512) : (u32x4){0u, 0u, 0u, 0u}; }
    f32x4 sma = {0.f, 0.f, 0.f, 0.f}, smb = sma;
#pragma unroll
    for (int r = 0; r < W - 1; ++r) { f32x4 a, c; unpack8(raw[r], a, c); sma += a; smb += c; }
#pragma unroll
    for (int j = 0; j < TS; ++j) { const int t = t0 + j; f32x4 a, c; unpack8(raw[W - 1 + j], a, c); sma += a; smb += c;
        const float inv = 1.0f / (float)((t + 1) < W ? (t + 1) : W);
        *(u32x4*)(mb + (size_t)t * 1024) = pack8((sma * inv - a + ba) * sa, (smb * inv - c + bb) * sb);
        f32x4 a2, c2; unpack8(raw[j], a2, c2); sma -= a2; smb -= c2; }
}
__device__ __forceinline__ int bx_() { int b = blockIdx.x; asm volatile("" : "+s"(b)); return b; }
__global__ void __launch_bounds__(512, 2) fwd_megakernel(Params p) {
    extern __shared__ __attribute__((aligned(16))) unsigned char lds_raw[];
    LAS unsigned char* lds = (LAS unsigned char*)lds_raw;
    cg::grid_group grid = cg::this_grid();
    const int G = gridDim.x;
    const int wave0 = __builtin_amdgcn_readfirstlane(threadIdx.x >> 6);
    { volatile LAS unsigned* xst = (volatile LAS unsigned*)(lds + 136 * 1024); if (threadIdx.x == 0) { xst[0] = 0u; xst[1] = 0u; } __syncthreads(); (void)xcd_barrier_post((unsigned*)(p.ws + WS_BAR), xst); }
#define GRID_BAR() do { XcdBarrier xb_; xb_.bar = (unsigned*)(p.ws + WS_BAR); xb_.x = xb_xcc_id(); xb_.st = (volatile LAS unsigned*)(lds + 136 * 1024); xcd_barrier(xb_, wave0 == 0 && lane_id_() == 0); } while (0)
#define FRESH_TID() int tid = wave0 * 64 + lane_id_(); asm volatile("" : "+v"(tid)); const size_t gtid = (size_t)blockIdx.x * 512 + tid, gsz = (size_t)G * 512; (void)gsz; (void)gtid;
    unsigned char* ws = p.ws;
    const float* x = p.in[0]; const float* pin = p.in[1];
    bf16_t* X1 = (bf16_t*)(ws + WS_X1); bf16_t* X2 = (bf16_t*)(ws + WS_X2); bf16_t* PB = (bf16_t*)p.out;
    signed char* LO = (signed char*)(ws + WS_PB);
    float* STATS = (float*)(ws + WS_STATS2); float* LBP = (float*)(ws + WS_LBP); float* BBAR = (float*)(ws + WS_BBAR); float* KMAT = (float*)(ws + WS_KMAT);
    bf16_t* PG = (bf16_t*)(ws + WS_PG); float* LOC = (float*)(ws + WS_LOC); bf16_t* BAUG = (bf16_t*)(ws + WS_BAUG);
    float* WCOMB = (float*)(ws + WS_WCOMB); float* CVEC = (float*)(ws + WS_CVEC);
    bf16_t* AAUG = (bf16_t*)(ws + WS_BIG + BIG_AAUG); bf16_t* Q = (bf16_t*)(ws + WS_BIG + BIG_Q); bf16_t* YG = (bf16_t*)(ws + WS_BIG + BIG_YG);
    bf16_t* MIX = (bf16_t*)(ws + WS_BIG + BIG_MIX); bf16_t* HID = (bf16_t*)(ws + WS_BIG); bf16_t* EB = (bf16_t*)(ws + WS_BIG + BIG_E);

    { FRESH_TID();
    for (size_t i = gtid; i < (size_t)NL_ * CVEC_PER_LAYER; i += gsz) CVEC[i] = 0.f;
    for (size_t i = gtid; i < (size_t)T_ * D_ / 8; i += gsz) { const f32x4 a = ((const f32x4*)x)[2 * i], b = ((const f32x4*)x)[2 * i + 1]; ((u32x4*)X1)[i] = pack8(a, b); }
    for (size_t i = gtid; i < (size_t)NL_ * T_ * PLE_ / 8; i += gsz) { const f32x4 a = ((const f32x4*)pin)[2 * i], b = ((const f32x4*)pin)[2 * i + 1]; ((u32x4*)PB)[i] = pack8(a, b); }
    for (size_t it = gtid; it < (size_t)NL_ * 32 * 64 * 66; it += gsz) {
        const int i = (int)(it / 66), k = (int)(it % 66), lg = i >> 6;
        const double ar = fmin((double)p.in[6][i], -1e-4), aim = (double)p.in[7][i], dt = exp((double)p.in[8][lg]);
        if (k <= 64) { const double mag = exp(ar * dt * k), ang = aim * dt * k; LBP[((size_t)i * 65 + k) * 2] = (float)(mag * cos(ang)); LBP[((size_t)i * 65 + k) * 2 + 1] = (float)(mag * sin(ang)); }
        else { const double mag = exp(ar * dt), ang = aim * dt; const double nr = mag * cos(ang) - 1.0, ni = mag * sin(ang), den = ar * ar + aim * aim;
            const double qr = (nr * ar + ni * aim) / den, qi = (ni * ar - nr * aim) / den;
            for (int c = 0; c < 16; ++c) { const double br = (double)p.in[9][(size_t)i * 16 + c], bi = (double)p.in[10][(size_t)i * 16 + c];
                BBAR[((size_t)i * 16 + c) * 2] = (float)(qr * br - qi * bi); BBAR[((size_t)i * 16 + c) * 2 + 1] = (float)(qr * bi + qi * br); } }
    }
    for (size_t i = gtid; i < (size_t)NL_ * 1024 * 512; i += gsz) {
        const int d = (int)(i & 127), gp = (int)((i >> 7) & 3), k = (int)((i >> 9) & 1023), l = (int)(i >> 19);
        const float* wi = p.in[2] + ((size_t)l * 1024 + k) * 1024 + gp * 128; const float* wp = p.in[3] + ((size_t)(l * 4 + gp) * 128) * 128 + d;
        float s = 0.f;
        for (int c = 0; c < 128; ++c) s += wi[c] * wp[(size_t)c * 128];
        WCOMB[i] = s;
    }
    }
    if (gridDim.x == 0x7fffffffu) grid.sync();
    GRID_BAR();

    { FRESH_TID();
    for (size_t i = gtid; i < (size_t)NL_ * 32 * 64 * 16; i += gsz) {
        const int c = (int)(i & 15), lag = (int)((i >> 4) & 63), lg = (int)(i >> 10);
        const float* cre = p.in[11] + ((size_t)lg * 16 + c) * 64; const float* cim = p.in[12] + ((size_t)lg * 16 + c) * 64;
        f32x4 s0 = {0.f, 0.f, 0.f, 0.f}, s1 = s0, s2 = s0, s3 = s0;
        for (int n = 0; n < 64; ++n) { const size_t sn = (size_t)lg * 64 + n; const f32x2 pw = *(const f32x2*)(LBP + (sn * 65 + lag) * 2);
            const float er = cre[n] * pw.x - cim[n] * pw.y, ei = cre[n] * pw.y + cim[n] * pw.x;
            const f32x4* bb = (const f32x4*)(BBAR + sn * 32);
#pragma unroll
            for (int q = 0; q < 8; ++q) { const f32x4 b = bb[q]; const float v0 = er * b[0] - ei * b[1], v1 = er * b[2] - ei * b[3];
                if (q < 2) { s0[(q & 1) * 2] += v0; s0[(q & 1) * 2 + 1] += v1; } else if (q < 4) { s1[(q & 1) * 2] += v0; s1[(q & 1) * 2 + 1] += v1; }
                else if (q < 6) { s2[(q & 1) * 2] += v0; s2[(q & 1) * 2 + 1] += v1; } else { s3[(q & 1) * 2] += v0; s3[(q & 1) * 2 + 1] += v1; } } }
        f32x4* dst = (f32x4*)(KMAT + i * 16); dst[0] = s0; dst[1] = s1; dst[2] = s2; dst[3] = s3;
    }
    for (size_t i = gtid; i < (size_t)NL_ * 32 * 128 * 128; i += gsz) {
        const int v = (int)(i & 127), nri = (int)((i >> 7) & 127), lg = (int)(i >> 14); const int sl = v >> 1, c0 = (v & 1) * 8, n = nri >> 1, ri = nri & 1;
        const size_t sn = (size_t)lg * 64 + n; const float pr = LBP[(sn * 65 + (63 - sl)) * 2], pi = LBP[(sn * 65 + (63 - sl)) * 2 + 1];
        float o[8];
#pragma unroll
        for (int j = 0; j < 8; ++j) { const float br = BBAR[(sn * 16 + c0 + j) * 2], bi = BBAR[(sn * 16 + c0 + j) * 2 + 1]; o[j] = ri ? (pr * bi + pi * br) : (pr * br - pi * bi); }
        u32x4 w; w.x = cvt_pk(o[0], o[1]); w.y = cvt_pk(o[2], o[3]); w.z = cvt_pk(o[4], o[5]); w.w = cvt_pk(o[6], o[7]);
        *(u32x4*)(PG + ((size_t)lg * 128 + nri) * 1024 + sl * 16 + c0) = w;
    }
    {
        float* tile = (float*)lds_raw; int base = 0; const int ttid = wave0 * 64 + lane_id_();
        for (int l = 0; l < NL_; ++l) {
            const float* g2p = l ? p.in[24] + (size_t)(l - 1) * 1024 : nullptr; const float* g1 = p.in[17] + (size_t)l * 1024;
            bf16_t* WIN = (bf16_t*)(ws + WS_WIN) + (size_t)l * 1024 * 1024;
            const float* b2p = l ? p.in[25] + (size_t)(l - 1) * 1024 : nullptr; const float* b1 = p.in[18] + (size_t)l * 1024; float* cvl = CVEC + (size_t)l * CVEC_PER_LAYER;
            transpose_job(tile, WCOMB + (size_t)l * 1024 * 512, 512, 1024, 512, g2p, WIN, 0, 0, base, b2p, l ? cvl : nullptr, cvl + 1024, 0, ttid);
            transpose_job(tile, p.in[2] + (size_t)l * 1024 * 1024 + 512, 1024, 1024, 512, g2p, WIN + (size_t)512 * 1024, 0, 0, base, b2p, l ? cvl : nullptr, cvl + 1024, 512, ttid);
            transpose_job(tile, p.in[16] + (size_t)l * 1024 * 1024, 1024, 1024, 1024, nullptr, (bf16_t*)(ws + WS_WOUT) + (size_t)l * 1024 * 1024, 0, 0, base, nullptr, nullptr, nullptr, 0, ttid);
            transpose_job(tile, p.in[23] + (size_t)l * 1024 * 1024, 1024, 1024, 1024, nullptr, (bf16_t*)(ws + WS_GATE) + (size_t)l * 1024 * 1024, 0, 0, base, nullptr, nullptr, nullptr, 0, ttid);
            transpose_job(tile, p.in[14] + (size_t)l * 512 * 512, 512, 512, 512, nullptr, (bf16_t*)(ws + WS_GLU) + (size_t)l * 512 * 512, 0, 0, base, nullptr, nullptr, nullptr, 0, ttid);
            transpose_job(tile, p.in[22] + (size_t)l * 256 * 1024, 1024, 256, 1024, nullptr, (bf16_t*)(ws + WS_PLE) + (size_t)l * 1024 * 256, 0, 0, base, nullptr, nullptr, nullptr, 0, ttid);
            transpose_job(tile, p.in[19] + (size_t)l * 1024 * H_, H_, 1024, H_, g1, (bf16_t*)(ws + WS_W13) + (size_t)l * 5632 * 1024, 1, 0, base, b1, cvl + 2048, cvl + 2048 + 5632, 0, ttid);
            transpose_job(tile, p.in[20] + (size_t)l * 1024 * H_, H_, 1024, H_, g1, (bf16_t*)(ws + WS_W13) + (size_t)l * 5632 * 1024, 1, 128, base, b1, cvl + 2048, cvl + 2048 + 5632, 0, ttid);
            transpose_job(tile, p.in[21] + (size_t)l * H_ * 1024, 1024, H_, 1024, nullptr, (bf16_t*)(ws + WS_W2) + (size_t)l * 1024 * H_, 0, 0, base, nullptr, nullptr, nullptr, 0, ttid);
        }
        __syncthreads();
    }
    }
    GRID_BAR();

    for (int l = 0; l < NL_; ++l) {
        const float* cv = CVEC + (size_t)l * CVEC_PER_LAYER;
        float* st1 = STATS + (size_t)(2 * l) * T_ * 8; float* st2 = STATS + (size_t)(2 * l + 1) * T_ * 8;
        const float* st2p = l ? STATS + (size_t)(2 * l - 1) * T_ * 8 : STATS;
        { Gemm g{X1, (const bf16_t*)(ws + WS_WIN) + (size_t)l * 1024 * 1024, 1024, 1024, 1024, 0, 0, 0}; Sched S; S.init(T_, 1024, 1, G, bx_());
          EpiIn E{st2p, cv, cv + 1024, Q, AAUG, l > 0}; gemm_phase(lds, g, S, E, wave0); }
        GRID_BAR();
        { Gemm g{AAUG, PG + (size_t)l * 32 * 128 * 1024, 1152, 1024, 1024, (size_t)1024 * 1152 * 2, (size_t)128 * 1024 * 2, 1}; Sched S; S.init(1024, 256, 32, G, bx_());
          EpiLoc E{LOC}; gemm_phase(lds, g, S, E, wave0);
          Unit u;
          if (S.next(0, u)) {
              FRESH_TID();
              __threadfence(); __syncthreads();
              const int bl = tid >> 6, n = tid & 63; const size_t sn = ((size_t)l * 32 + u.g) * 64 + n;
              const float ar = LBP[(sn * 65 + 64) * 2], ai_ = LBP[(sn * 65 + 64) * 2 + 1];
              float sr = 0.f, si = 0.f;
              const size_t row0 = (size_t)u.g * 1024 + u.pm * 256 + bl * 32;
              for (int j0 = 0; j0 < 32; j0 += 8) {
                  f32x2 lc[8];
#pragma unroll
                  for (int j = 0; j < 8; ++j) lc[j] = *(const f32x2*)(LOC + (row0 + j0 + j) * 128 + 2 * n);
#pragma unroll
                  for (int j = 0; j < 8; ++j) { *(unsigned*)(AAUG + (row0 + j0 + j) * 1152 + 1024 + 2 * n) = cvt_pk(sr, si);
                      const float nr = ar * sr - ai_ * si + lc[j].x, ni = ar * si + ai_ * sr + lc[j].y; sr = nr; si = ni; }
              }
          }
        }
        {
            FRESH_TID();
            for (size_t it = gtid; it < (size_t)32 * 256 * 64; it += gsz) {
                const int c16 = (int)(it & 15), tch = (int)((it >> 4) & 255), grp = (int)((it >> 12) & 3), b = (int)(it >> 14); const int cvv = grp * 16 + c16, t0 = tch * 8;
                const bf16_t* qb = Q + (size_t)b * SEQ_ * 512 + cvv * 8; bf16_t* mb = MIX + (size_t)b * SEQ_ * 1024 + cvv * 8;
                const float* pb = p.in[4] + (size_t)l * 512 + cvv * 8; const float* ps = p.in[5] + (size_t)l * 512 + cvv * 8;
                const f32x4 ba = *(const f32x4*)pb, bb = *(const f32x4*)(pb + 4), sa = *(const f32x4*)ps, sb = *(const f32x4*)(ps + 4);
                if (grp == 0) fir_item<2>(qb, mb, t0, ba, bb, sa, sb); else if (grp == 1) fir_item<4>(qb, mb, t0, ba, bb, sa, sb);
                else if (grp == 2) fir_item<8>(qb, mb, t0, ba, bb, sa, sb); else fir_item<16>(qb, mb, t0, ba, bb, sa, sb);
            }
        }
        const int nsw = G, swi = (int)blockIdx.x;
        { FRESH_TID();
        const float* kmat_l = KMAT + (size_t)l * 32 * 64 * 256;
        for (size_t i0 = gtid; i0 < (size_t)32 * 1024 * 128; i0 += 4 * gsz) {
            f32x4 a[4], b[4]; bool nz[4];
#pragma unroll
            for (int j = 0; j < 4; ++j) { const size_t i = i0 + j * gsz; const int kv = (int)(i & 127), rowi = (int)((i >> 7) & 1023), gg = (int)(i >> 17); const int tl = rowi >> 4, c = rowi & 15, sl = kv >> 1, c0 = (kv & 1) * 8;
                nz[j] = (i < (size_t)32 * 1024 * 128) && (sl <= tl);
                if (nz[j]) { const float* km = kmat_l + ((((size_t)gg * 64 + (tl - sl)) * 16 + c) * 16 + c0); a[j] = *(const f32x4*)km; b[j] = *(const f32x4*)(km + 4); }
                else { a[j] = (f32x4){0.f, 0.f, 0.f, 0.f}; b[j] = a[j]; } }
#pragma unroll
            for (int j = 0; j < 4; ++j) { const size_t i = i0 + j * gsz; if (i < (size_t)32 * 1024 * 128) { const int kv = (int)(i & 127); const size_t grow = i >> 7;
                *(u32x4*)(BAUG + grow * 1152 + kv * 8) = pack8(a[j], b[j]); } }
        }
        for (size_t i = gtid; i < (size_t)32 * 1024 * 16; i += gsz) {
            const int kv = (int)(i & 15), rowi = (int)((i >> 4) & 1023), gg = (int)(i >> 14); const int tl = rowi >> 4, c = rowi & 15, n0 = kv * 4; const size_t lg = (size_t)l * 32 + gg;
            const f32x4 cr = *(const f32x4*)(p.in[11] + (lg * 16 + c) * 64 + n0), ci = *(const f32x4*)(p.in[12] + (lg * 16 + c) * 64 + n0);
            float o[8];
#pragma unroll
            for (int j = 0; j < 4; ++j) { const f32x2 pw = *(const f32x2*)(LBP + ((lg * 64 + n0 + j) * 65 + tl + 1) * 2); o[2 * j] = cr[j] * pw.x - ci[j] * pw.y; o[2 * j + 1] = -(cr[j] * pw.y + ci[j] * pw.x); }
            u32x4 w; w.x = cvt_pk(o[0], o[1]); w.y = cvt_pk(o[2], o[3]); w.z = cvt_pk(o[4], o[5]); w.w = cvt_pk(o[6], o[7]);
            *(u32x4*)(BAUG + ((size_t)gg * 1024 + rowi) * 1152 + 1024 + kv * 8) = w;
        }
        }
        GRID_BAR();
        { Gemm g{AAUG, BAUG, 1152, 1152, 1152, (size_t)1024 * 1152 * 2, (size_t)1024 * 1152 * 2, 0}; Sched S; S.init(1024, 1024, 32, G, bx_());
          EpiSsm E{AAUG, p.in[13] + (size_t)l * 512, YG}; gemm_phase(lds, g, S, E, wave0); }
        GRID_BAR();
        { Gemm g{YG, (const bf16_t*)(ws + WS_GLU) + (size_t)l * 512 * 512, 512, 512, 512, 0, 0, 0}; Sched S; S.init(T_, 512, 1, G, bx_());
          EpiGlu E{YG, p.in[15] + (size_t)l * 512, MIX}; gemm_phase(lds, g, S, E, wave0); }
        GRID_BAR();
        { Gemm g{MIX, (const bf16_t*)(ws + WS_WOUT) + (size_t)l * 1024 * 1024, 1024, 1024, 1024, 0, 0, 0}; Sched S; S.init(T_, 1024, 1, G, bx_());
          if (l == 0) { EpiRes<true, true> E{x, nullptr, st2p, x, x, 0, X1, LO, st1, lds + 128 * 1024}; gemm_phase(lds, g, S, E, wave0); }
          else { EpiRes<true, false> E{nullptr, X1, st2p, p.in[24] + (size_t)(l - 1) * 1024, p.in[25] + (size_t)(l - 1) * 1024, 1, X1, LO, st1, lds + 128 * 1024}; gemm_phase(lds, g, S, E, wave0); } }
        GRID_BAR();
        { Gemm g{X1, (const bf16_t*)(ws + WS_W13) + (size_t)l * 5632 * 1024, 1024, 1024, 1024, 0, 0, 0}; Sched S; S.init(T_, 5632, 1, G, bx_());
          { LAS int* tg = (LAS int*)(lds + 140 * 1024 + 2048); if (wave0 == 0) { const int ln_ = lane_id_(); if (ln_ < 8) tg[ln_] = 0; } __syncthreads(); }
          EpiFfn E{st1, cv + 2048, cv + 2048 + 5632, HID, lds + 140 * 1024}; gemm_phase(lds, g, S, E, wave0); }
        GRID_BAR();
        { Gemm g{HID, (const bf16_t*)(ws + WS_W2) + (size_t)l * 1024 * H_, H_, H_, H_, 0, 0, 0}; Sched S; S.init(T_, 1024, 1, G, bx_());
          EpiRes<false, false> E{nullptr, X1, st1, p.in[17] + (size_t)l * 1024, p.in[18] + (size_t)l * 1024, 1, X2, LO, nullptr, lds + 128 * 1024}; gemm_phase(lds, g, S, E, wave0); }
        GRID_BAR();
        { Gemm g{PB + (size_t)l * T_ * PLE_, (const bf16_t*)(ws + WS_PLE) + (size_t)l * 1024 * 256, 256, 256, 256, 0, 0, 0}; Sched S; S.init(T_, 1024, 1, G, bx_());
          EpiPle E{EB}; gemm_phase(lds, g, S, E, wave0); }
        { Gemm g{X2, (const bf16_t*)(ws + WS_GATE) + (size_t)l * 1024 * 1024, 1024, 1024, 1024, 0, 0, 0}; Sched S; S.init(T_, 1024, 1, G, bx_());
          EpiGate E{EB, X2, X1, LO, st2, lds + 128 * 1024}; gemm_phase(lds, g, S, E, wave0); }
        GRID_BAR();
    }
    {
        FRESH_TID();
        const float* st = STATS + (size_t)(2 * NL_ - 1) * T_ * 8; const float* gam = p.in[24] + (size_t)(NL_ - 1) * 1024; const float* bet = p.in[25] + (size_t)(NL_ - 1) * 1024;
        for (size_t i = gtid; i < (size_t)T_ * D_ / 8; i += gsz) { const int row = (int)(i >> 7), c = (int)(i & 127) * 8; float mu, rstd; row_stats(st, row, true, mu, rstd);
            f32x4 va, vb; hl_load(X1, LO, row, c, va, vb);
            ((f32x4*)p.out)[2 * i] = (va - mu) * rstd * *(const f32x4*)(gam + c) + *(const f32x4*)(bet + c);
            ((f32x4*)p.out)[2 * i + 1] = (vb - mu) * rstd * *(const f32x4*)(gam + c + 4) + *(const f32x4*)(bet + c + 4); }
    }
}

extern "C" void kernel_launch(void* const* d_in, const int* in_sizes, int n_in, void* d_out, int out_size, void* d_ws, size_t ws_size, hipStream_t stream) {
    static int grid = 0;
    if (!grid) {
        int dev = 0, cus = 0, per_cu = 0;
        (void)hipGetDevice(&dev);
        (void)hipDeviceGetAttribute(&cus, hipDeviceAttributeMultiprocessorCount, dev);
        if (hipFuncSetAttribute((const void*)fwd_megakernel, hipFuncAttributeMaxDynamicSharedMemorySize, LDS_BYTES) != hipSuccess) fprintf(stderr, "hipFuncSetAttribute failed\n");
        (void)hipOccupancyMaxActiveBlocksPerMultiprocessor(&per_cu, (const void*)fwd_megakernel, 512, LDS_BYTES);
        if (per_cu < 1) fprintf(stderr, "occupancy query says %d blocks per CU\n", per_cu);
        if (ws_size < WS_END || n_in != 26 || out_size != T_ * D_) fprintf(stderr, "unexpected sizes: ws %zu n_in %d out %d\n", ws_size, n_in, out_size);
        grid = cus > 0 ? cus : 256;
    }
    if (hipMemsetAsync((unsigned char*)d_ws + WS_BAR, 0, XCD_BAR_WORDS * 4, stream) != hipSuccess) fprintf(stderr, "memset of the barrier words failed\n");
    Params p{};
    for (int i = 0; i < 26; ++i) p.in[i] = (const float*)d_in[i];
    p.out = (float*)d_out; p.ws = (unsigned char*)d_ws;
    void* args[] = {&p};
    hipError_t e = hipLaunchCooperativeKernel((const void*)fwd_megakernel, dim3(grid), dim3(512), args, LDS_BYTES, stream);
    if (e != hipSuccess) fprintf(stderr, "cooperative launch failed: %s (grid %d)\n", hipGetErrorString(e), grid);
}
```
